# Optimizing an MI355X kernel written in HIP

```python
import jax, jax.numpy as jnp
from jax import lax
import numpy as np

D_MODEL = 1024
BATCH = 1
SEQ = 16384
DEPTH = 1

D_MIX = D_MODEL
RET_HEADS = 4
RET_QK_DIM = 64
RET_V_DIM = 128
RET_QK = RET_HEADS * RET_QK_DIM
RET_WIDTH = RET_HEADS * RET_V_DIM
GDN_HEADS = 4
GDN_HEAD_DIM = 128
GDN_WIDTH = GDN_HEADS * GDN_HEAD_DIM
CONV_K = 4
CONV_CH = 3 * GDN_WIDTH
CHUNK = 128
ROPE_BASE = 10000.0
NORM_EPS = 1e-6
PEER_HEADS = 8
PEER_KEYS = 128
PEER_EXPERTS = PEER_KEYS * PEER_KEYS
PEER_QDIM = 256
PEER_HALF = PEER_QDIM // 2
PEER_TOPK = 16
PEER_BLOCK = 128
SPLITS = (RET_QK, RET_QK, RET_WIDTH, RET_WIDTH, GDN_WIDTH, GDN_WIDTH, GDN_WIDTH, GDN_WIDTH, GDN_HEADS, GDN_HEADS)
IN_COLS = sum(SPLITS)

kernel_name = 'hybrid_retention_gdn_peer'


def _rmsnorm(x, w):
    xf = x.astype(jnp.float32)
    y = xf * lax.rsqrt(jnp.mean(xf * xf, axis=-1, keepdims=True) + NORM_EPS)
    return (y * w.astype(jnp.float32)).astype(x.dtype)


def _heads(t, n_heads):
    b, t_len, _ = t.shape
    return t.reshape(b, t_len, n_heads, -1).transpose(0, 2, 1, 3)


def _rope(t):
    t_len, d = t.shape[-2], t.shape[-1]
    half = d // 2
    inv = ROPE_BASE ** (-jnp.arange(half, dtype=jnp.float32) / half)
    ang = jnp.arange(t_len, dtype=jnp.float32)[:, None] * inv[None, :]
    cos, sin = jnp.cos(ang), jnp.sin(ang)
    t1, t2 = t[..., :half], t[..., half:]
    return jnp.concatenate([t1 * cos - t2 * sin, t1 * sin + t2 * cos], axis=-1)


def _retention(q, k, v):
    b, h, t_len, dk = q.shape
    n = t_len // CHUNK
    lg = jnp.log1p(-jnp.exp2(-5.0 - jnp.arange(h, dtype=jnp.float32)))
    k = k * (dk ** -0.5)
    q = q.reshape(b, h, n, CHUNK, dk)
    k = k.reshape(b, h, n, CHUNK, dk)
    v = v.reshape(b, h, n, CHUNK, -1)
    idx = jnp.arange(CHUNK, dtype=jnp.float32)
    diff = idx[:, None] - idx[None, :]
    decay = jnp.where(diff >= 0, jnp.exp(lg[:, None, None] * jnp.maximum(diff, 0.0)), 0.0)
    scores = jnp.einsum('bhnid,bhnjd->bhnij', q, k) * decay[None, :, None]
    intra = jnp.einsum('bhnij,bhnje->bhnie', scores, v)
    k_dec = k * jnp.exp(lg[:, None] * (CHUNK - 1.0 - idx))[None, :, None, :, None]
    chunk_kv = jnp.einsum('bhncd,bhnce->nbhde', k_dec, v)
    chunk_decay = jnp.exp(lg * CHUNK)[None, :, None, None]

    def step(state, kv):
        return state * chunk_decay + kv, state

    _, s_prev = lax.scan(step, jnp.zeros_like(chunk_kv[0]), chunk_kv)
    q_dec = q * jnp.exp(lg[:, None] * (idx + 1.0))[None, :, None, :, None]
    inter = jnp.einsum('bhncd,nbhde->bhnce', q_dec, s_prev)
    return (intra + inter).reshape(b, h, t_len, -1)


def _gated_delta_rule(q, k, v, g, beta):
    b, h, t_len, dk = q.shape
    dv = v.shape[-1]
    n = t_len // CHUNK
    q = (q * (dk ** -0.5)).reshape(b, h, n, CHUNK, dk)
    k = k.reshape(b, h, n, CHUNK, dk)
    v = v.reshape(b, h, n, CHUNK, dv)
    g = g.reshape(b, h, n, CHUNK)
    beta = beta.reshape(b, h, n, CHUNK)
    gc = jnp.cumsum(g, axis=-1)
    causal = jnp.tril(jnp.ones((CHUNK, CHUNK), dtype=bool))
    strict = jnp.tril(jnp.ones((CHUNK, CHUNK), dtype=bool), -1)
    gdiff = gc[..., :, None] - gc[..., None, :]
    lmask = jnp.where(causal, jnp.exp(jnp.where(causal, gdiff, 0.0)), 0.0)
    kb = k * beta[..., None]
    kkt = jnp.einsum('bhnid,bhnjd->bhnij', kb, k) * lmask
    m = jnp.eye(CHUNK, dtype=kkt.dtype) + jnp.where(strict, kkt, 0.0)
    rhs = jnp.concatenate([v * beta[..., None], kb * jnp.exp(gc)[..., None]], axis=-1)
    sol = lax.linalg.triangular_solve(m, rhs, left_side=True, lower=True, unit_diagonal=True)
    u, w = sol[..., :dv], sol[..., dv:]
    attn = jnp.einsum('bhnid,bhnjd->bhnij', q, k) * lmask
    q_dec = q * jnp.exp(gc)[..., None]
    glast = gc[..., -1:]
    k_st = k * jnp.exp(glast - gc)[..., None]
    dec = jnp.exp(glast[..., 0])
    xs = tuple(jnp.moveaxis(t, 2, 0) for t in (q_dec, attn, u, w, k_st, dec))

    def step(state, inp):
        qd, at, uc, wc, ks, dc = inp
        v_new = uc - jnp.einsum('bhcd,bhde->bhce', wc, state)
        o = jnp.einsum('bhcd,bhde->bhce', qd, state) + jnp.einsum('bhij,bhje->bhie', at, v_new)
        state = state * dc[..., None, None] + jnp.einsum('bhcd,bhce->bhde', ks, v_new)
        return state, o

    s0 = jnp.zeros((b, h, dk, dv), dtype=q.dtype)
    _, o = lax.scan(step, s0, xs)
    return jnp.moveaxis(o, 0, 2).reshape(b, h, t_len, dv)


def _causal_short_conv(x, w):
    ch = x.shape[-1]
    return lax.conv_general_dilated(x, w[:, None, :], window_strides=(1,), padding=[(CONV_K - 1, 0)],
                                    dimension_numbers=('NWC', 'WIO', 'NWC'), feature_group_count=ch)


def _peer(h, wq, sub_keys, u_tab, v_tab):
    b, t_len, d = h.shape
    hb = h.reshape(-1, PEER_BLOCK, d)

    def block(xb):
        q = (xb @ wq).reshape(PEER_BLOCK, PEER_HEADS, 2, PEER_HALF)
        s = jnp.einsum('thpd,hpkd->thpk', q, sub_keys).astype(jnp.float32)
        s1, i1 = lax.top_k(s[:, :, 0], PEER_TOPK)
        s2, i2 = lax.top_k(s[:, :, 1], PEER_TOPK)
        cand = (s1[..., :, None] + s2[..., None, :]).reshape(PEER_BLOCK, PEER_HEADS, -1)
        cid = (i1[..., :, None] * PEER_KEYS + i2[..., None, :]).reshape(PEER_BLOCK, PEER_HEADS, -1)
        best, pos = lax.top_k(cand, PEER_TOPK)
        ids = jnp.take_along_axis(cid, pos, axis=-1).reshape(PEER_BLOCK, -1)
        gate = jax.nn.softmax(best, axis=-1).reshape(PEER_BLOCK, -1)
        act = jax.nn.gelu(jnp.einsum('tkd,td->tk', u_tab[ids], xb).astype(jnp.float32), approximate=False)
        return jnp.einsum('tk,tkd->td', (gate * act).astype(xb.dtype), v_tab[ids])

    return lax.map(block, hb).reshape(b, t_len, d)


def setup_inputs(seed: int = 0) -> dict:
    key = jax.random.key(seed)
    ks = jax.random.split(key, 16)
    f32 = jnp.float32

    def nrm(k, shape, scale):
        return jax.random.normal(k, shape, f32) * scale

    x = nrm(ks[0], (BATCH, SEQ, D_MODEL), 1.0)
    ln1_w = 1.0 + nrm(ks[1], (DEPTH, D_MODEL), 0.02)
    w_in = nrm(ks[2], (DEPTH, D_MODEL, IN_COLS), D_MODEL ** -0.5)
    ret_norm_w = 1.0 + nrm(ks[3], (DEPTH, RET_WIDTH), 0.02)
    conv_w = nrm(ks[4], (DEPTH, CONV_K, CONV_CH), CONV_K ** -0.5)
    A_log = jnp.log(jax.random.uniform(ks[5], (DEPTH, GDN_HEADS), f32, 1.0, 16.0))
    dt = jnp.exp(jax.random.uniform(ks[6], (DEPTH, GDN_HEADS), f32, np.log(1e-3), np.log(1e-1)))
    dt_bias = dt + jnp.log(-jnp.expm1(-dt))
    gdn_norm_w = 1.0 + nrm(ks[7], (DEPTH, GDN_HEAD_DIM), 0.02)
    w_out = nrm(ks[8], (DEPTH, D_MIX, D_MODEL), D_MIX ** -0.5)
    ln2_w = 1.0 + nrm(ks[9], (DEPTH, D_MODEL), 0.02)
    peer_wq = nrm(ks[10], (DEPTH, D_MODEL, PEER_HEADS * PEER_QDIM), D_MODEL ** -0.5)
    peer_keys = nrm(ks[11], (DEPTH, PEER_HEADS, 2, PEER_KEYS, PEER_HALF), PEER_HALF ** -0.5)
    peer_u = nrm(ks[12], (DEPTH, PEER_EXPERTS, D_MODEL), D_MODEL ** -0.5)
    peer_v = nrm(ks[13], (DEPTH, PEER_EXPERTS, D_MODEL), PEER_HEADS ** -0.5)
    lnf_w = 1.0 + nrm(ks[14], (D_MODEL,), 0.02)
    return {'x': x, 'ln1_w': ln1_w, 'w_in': w_in, 'ret_norm_w': ret_norm_w, 'conv_w': conv_w,
            'A_log': A_log, 'dt_bias': dt_bias, 'gdn_norm_w': gdn_norm_w, 'w_out': w_out,
            'ln2_w': ln2_w, 'peer_wq': peer_wq, 'peer_keys': peer_keys, 'peer_u': peer_u,
            'peer_v': peer_v, 'lnf_w': lnf_w}


def reference(x, ln1_w, w_in, ret_norm_w, conv_w, A_log, dt_bias, gdn_norm_w, w_out,
              ln2_w, peer_wq, peer_keys, peer_u, peer_v, lnf_w):
    f32 = jnp.float32
    offsets = [int(o) for o in np.cumsum(SPLITS)[:-1]]
    for l in range(DEPTH):
        h = _rmsnorm(x, ln1_w[l])
        proj = (h @ w_in[l]).astype(f32)
        rq, rk, rv, rg, gq, gk, gv, gz, ga, gb = jnp.split(proj, offsets, axis=-1)

        q_r = _rope(_heads(rq, RET_HEADS))
        k_r = _rope(_heads(rk, RET_HEADS))
        o_r = _retention(q_r, k_r, _heads(rv, RET_HEADS))
        mu = jnp.mean(o_r, axis=-1, keepdims=True)
        var = jnp.mean(jnp.square(o_r - mu), axis=-1, keepdims=True)
        o_r = ((o_r - mu) * lax.rsqrt(var + NORM_EPS)).transpose(0, 2, 1, 3).reshape(x.shape[0], x.shape[1], RET_WIDTH)
        y_r = o_r * ret_norm_w[l].astype(f32) * jax.nn.silu(rg)

        qkv = jax.nn.silu(_causal_short_conv(jnp.concatenate([gq, gk, gv], axis=-1), conv_w[l].astype(f32)))
        cq, ck, cv = jnp.split(qkv, 3, axis=-1)
        q_g = _heads(cq, GDN_HEADS)
        k_g = _heads(ck, GDN_HEADS)
        q_g = q_g * lax.rsqrt(jnp.sum(q_g * q_g, axis=-1, keepdims=True) + NORM_EPS)
        k_g = k_g * lax.rsqrt(jnp.sum(k_g * k_g, axis=-1, keepdims=True) + NORM_EPS)
        g_dec = -jnp.exp(A_log[l].astype(f32)) * jax.nn.softplus(ga + dt_bias[l].astype(f32))
        beta = jax.nn.sigmoid(gb)
        o_g = _gated_delta_rule(q_g, k_g, _heads(cv, GDN_HEADS),
                                g_dec.transpose(0, 2, 1), beta.transpose(0, 2, 1))
        o_g = _rmsnorm(o_g.transpose(0, 2, 1, 3), gdn_norm_w[l].astype(f32))
        y_g = o_g.reshape(x.shape[0], x.shape[1], GDN_WIDTH) * jax.nn.silu(gz)

        mixed = jnp.concatenate([y_r, y_g], axis=-1).astype(x.dtype)
        x = x + mixed @ w_out[l]

        h2 = _rmsnorm(x, ln2_w[l])
        x = x + _peer(h2, peer_wq[l], peer_keys[l], peer_u[l], peer_v[l])
    return _rmsnorm(x, lnf_w)
```

```cpp
#include <hip/hip_runtime.h>
#include <stdint.h>

typedef unsigned short bf16_t;
typedef __attribute__((ext_vector_type(8))) short bf16x8;
typedef __attribute__((ext_vector_type(4))) float f32x4;

constexpr int T_ = 16384;
constexpr int NPROJ = 3584;
constexpr int LDWIN = 3592;
constexpr float EPS = 1e-6f;

constexpr int C_RQ = 0, C_RK = 256, C_RV = 512, C_RG = 1024, C_GQ = 1536, C_GK = 2048, C_GV = 2560, C_GZ = 3072;

__constant__ double INVREV[32] = {0.15915494309189535, 0.11934937021124886, 0.08949940160889101, 0.06711508300522726, 0.050329212104487035, 0.03774158471741977, 0.0283021958306234, 0.02122365276477766, 0.015915494309189534, 0.011934937021124886, 0.0089499401608891, 0.006711508300522725, 0.005032921210448704, 0.003774158471741977, 0.00283021958306234, 0.002122365276477766, 0.0015915494309189536, 0.0011934937021124887, 0.0008949940160889102, 0.0006711508300522725, 0.0005032921210448703, 0.0003774158471741977, 0.00028302195830623395, 0.00021223652764777658, 0.00015915494309189535, 0.00011934937021124886, 8.9499401608891e-05, 6.711508300522725e-05, 5.0329212104487035e-05, 3.774158471741978e-05, 2.83021958306234e-05, 2.122365276477766e-05};

__device__ __forceinline__ bf16_t f2bf(float f) {
    unsigned u = __float_as_uint(f);
    u += 0x7fffu + ((u >> 16) & 1u);
    return (bf16_t)(u >> 16);
}
__device__ __forceinline__ float bf2f(bf16_t h) { return __uint_as_float(((unsigned)h) << 16); }
__device__ __forceinline__ float wave_sum(float v) {
#pragma unroll
    for (int o = 32; o > 0; o >>= 1) v += __shfl_xor(v, o);
    return v;
}
__device__ __forceinline__ float silu(float x) { return x / (1.f + __expf(-x)); }
__device__ __forceinline__ unsigned fkey(float f) { unsigned u = __float_as_uint(f); return (u & 0x80000000u) ? ~u : (u | 0x80000000u); }
__device__ __forceinline__ float keyf(unsigned k) { return __uint_as_float((k & 0x80000000u) ? (k & 0x7fffffffu) : ~k); }

__global__ __launch_bounds__(256) void k_prep_x(const float* __restrict__ x, const float* __restrict__ ln1_w, const float* __restrict__ w_in,
                                                const float* __restrict__ A_log, const float* __restrict__ dt_bias,
                                                bf16_t* __restrict__ xb, float* __restrict__ r1, float* __restrict__ gdec, float* __restrict__ beta) {
    const int wave = threadIdx.x >> 6, lane = threadIdx.x & 63;
    const int row = blockIdx.x * 4 + wave;
    const float* xr = x + (size_t)row * 1024;
    float ss = 0.f;
    float g0 = 0, g1 = 0, g2 = 0, g3 = 0, g4 = 0, g5 = 0, g6 = 0, g7 = 0;
#pragma unroll
    for (int j = 0; j < 4; ++j) {
        const int c = j * 256 + lane * 4;
        const float4 v = *(const float4*)(xr + c);
        const float4 w = *(const float4*)(ln1_w + c);
        ss += v.x * v.x + v.y * v.y + v.z * v.z + v.w * v.w;
        ushort4 o; o.x = f2bf(v.x); o.y = f2bf(v.y); o.z = f2bf(v.z); o.w = f2bf(v.w);
        *(ushort4*)(xb + (size_t)row * 1024 + c) = o;
        const float xs[4] = {v.x * w.x, v.y * w.y, v.z * w.z, v.w * w.w};
#pragma unroll
        for (int e = 0; e < 4; ++e) {
            const float* wp = w_in + (size_t)(c + e) * LDWIN + NPROJ;
            const float4 a = *(const float4*)wp; const float4 b = *(const float4*)(wp + 4);
            g0 += xs[e] * a.x; g1 += xs[e] * a.y; g2 += xs[e] * a.z; g3 += xs[e] * a.w;
            g4 += xs[e] * b.x; g5 += xs[e] * b.y; g6 += xs[e] * b.z; g7 += xs[e] * b.w;
        }
    }
    ss = wave_sum(ss);
    g0 = wave_sum(g0); g1 = wave_sum(g1); g2 = wave_sum(g2); g3 = wave_sum(g3);
    g4 = wave_sum(g4); g5 = wave_sum(g5); g6 = wave_sum(g6); g7 = wave_sum(g7);
    const float r = rsqrtf(ss * (1.f / 1024.f) + EPS);
    if (lane == 0) {
        r1[row] = r;
        const float ga[4] = {g0 * r, g1 * r, g2 * r, g3 * r};
        const float gb[4] = {g4 * r, g5 * r, g6 * r, g7 * r};
#pragma unroll
        for (int h = 0; h < 4; ++h) {
            const float xx = ga[h] + dt_bias[h];
            const float sp = xx > 20.f ? xx : log1pf(expf(xx));
            gdec[row * 4 + h] = -expf(A_log[h]) * sp;
            beta[row * 4 + h] = 1.f / (1.f + expf(-gb[h]));
        }
    }
}

__global__ __launch_bounds__(256) void k_transpose(const float* __restrict__ src, int ld, const float* __restrict__ scale, bf16_t* __restrict__ dst, int K) {
    __shared__ float tile[32][33];
    const int n0 = blockIdx.x * 32, k0 = blockIdx.y * 32;
    const int tx = threadIdx.x & 31, ty = threadIdx.x >> 5;
#pragma unroll
    for (int j = 0; j < 4; ++j) {
        const int k = k0 + ty + 8 * j;
        const float s = scale ? scale[k] : 1.f;
        tile[ty + 8 * j][tx] = src[(size_t)k * ld + n0 + tx] * s;
    }
    __syncthreads();
#pragma unroll
    for (int j = 0; j < 4; ++j) {
        const int n = n0 + ty + 8 * j;
        dst[(size_t)n * K + k0 + tx] = f2bf(tile[tx][ty + 8 * j]);
    }
}

__global__ __launch_bounds__(256) void k_convert(const float* __restrict__ src, bf16_t* __restrict__ dst, int n4) {
    const int i = blockIdx.x * 256 + threadIdx.x;
    if (i < n4) {
        const float4 v = ((const float4*)src)[i];
        ushort4 o; o.x = f2bf(v.x); o.y = f2bf(v.y); o.z = f2bf(v.z); o.w = f2bf(v.w);
        ((ushort4*)dst)[i] = o;
    }
}

constexpr int GLD = 72;
template <int EPI>
__global__ __launch_bounds__(256) void k_gemm(const bf16_t* __restrict__ A, int lda, const bf16_t* __restrict__ Bt, int ldb, int K,
                                              void* __restrict__ Cv, int ldc, const float* __restrict__ aux, int ntn) {
    __shared__ __attribute__((aligned(16))) bf16_t As[2][128][GLD];
    __shared__ __attribute__((aligned(16))) bf16_t Bs[2][128][GLD];
    const int tid = threadIdx.x, lane = tid & 63, w = tid >> 6;
    const int wr = w >> 1, wc = w & 1, r = lane & 15, quad = lane >> 4;
    const int tm = blockIdx.x / ntn, tn = blockIdx.x % ntn;
    const int m0 = tm * 128, n0 = tn * 128;
    const bf16_t* Ag = A + (size_t)m0 * lda;
    const bf16_t* Bg = Bt + (size_t)n0 * ldb;
    f32x4 acc[4][4];
#pragma unroll
    for (int i = 0; i < 4; ++i)
#pragma unroll
        for (int j = 0; j < 4; ++j) acc[i][j] = (f32x4){0.f, 0.f, 0.f, 0.f};
    uint4 ra[4], rb[4];
    const int nk = K / 64;
#pragma unroll
    for (int j = 0; j < 4; ++j) {
        const int c = tid + 256 * j, row = c >> 3, cc = c & 7;
        ra[j] = *(const uint4*)(Ag + (size_t)row * lda + cc * 8);
        rb[j] = *(const uint4*)(Bg + (size_t)row * ldb + cc * 8);
    }
#pragma unroll
    for (int j = 0; j < 4; ++j) {
        const int c = tid + 256 * j, row = c >> 3, cc = c & 7;
        *(uint4*)&As[0][row][cc * 8] = ra[j];
        *(uint4*)&Bs[0][row][cc * 8] = rb[j];
    }
    __syncthreads();
    for (int kt = 0; kt < nk; ++kt) {
        const int buf = kt & 1;
        const int kn = (kt + 1 < nk) ? kt + 1 : kt;
#pragma unroll
        for (int j = 0; j < 4; ++j) {
            const int c = tid + 256 * j, row = c >> 3, cc = c & 7;
            ra[j] = *(const uint4*)(Ag + (size_t)row * lda + kn * 64 + cc * 8);
            rb[j] = *(const uint4*)(Bg + (size_t)row * ldb + kn * 64 + cc * 8);
        }
        const bf16_t (*Ab)[GLD] = As[buf];
        const bf16_t (*Bb)[GLD] = Bs[buf];
#pragma unroll
        for (int ks = 0; ks < 2; ++ks) {
            bf16x8 a[4], b[4];
#pragma unroll
            for (int i = 0; i < 4; ++i) a[i] = *(const bf16x8*)&Ab[wr * 64 + i * 16 + r][ks * 32 + quad * 8];
#pragma unroll
            for (int j = 0; j < 4; ++j) b[j] = *(const bf16x8*)&Bb[wc * 64 + j * 16 + r][ks * 32 + quad * 8];
#pragma unroll
            for (int i = 0; i < 4; ++i)
#pragma unroll
                for (int j = 0; j < 4; ++j) acc[i][j] = __builtin_amdgcn_mfma_f32_16x16x32_bf16(b[j], a[i], acc[i][j], 0, 0, 0);
        }
        bf16_t (*An)[GLD] = As[buf ^ 1];
        bf16_t (*Bn)[GLD] = Bs[buf ^ 1];
#pragma unroll
        for (int j = 0; j < 4; ++j) {
            const int c = tid + 256 * j, row = c >> 3, cc = c & 7;
            *(uint4*)&An[row][cc * 8] = ra[j];
            *(uint4*)&Bn[row][cc * 8] = rb[j];
        }
        __syncthreads();
    }
#pragma unroll
    for (int i = 0; i < 4; ++i) {
        const int row = m0 + wr * 64 + i * 16 + r;
        float rs = 1.f;
        if (EPI == 0) rs = aux[row];
#pragma unroll
        for (int j = 0; j < 4; ++j) {
            const int col = n0 + wc * 64 + j * 16 + quad * 4;
            if (EPI == 0) {
                ushort4 o; o.x = f2bf(acc[i][j][0] * rs); o.y = f2bf(acc[i][j][1] * rs); o.z = f2bf(acc[i][j][2] * rs); o.w = f2bf(acc[i][j][3] * rs);
                *(ushort4*)((bf16_t*)Cv + (size_t)row * ldc + col) = o;
            } else {
                const float4 xr = *(const float4*)(aux + (size_t)row * ldc + col);
                float4 o; o.x = xr.x + acc[i][j][0]; o.y = xr.y + acc[i][j][1]; o.z = xr.z + acc[i][j][2]; o.w = xr.w + acc[i][j][3];
                *(float4*)((float*)Cv + (size_t)row * ldc + col) = o;
            }
        }
    }
}

__global__ __launch_bounds__(256) void k_preproc(const bf16_t* __restrict__ projb, const float* __restrict__ conv_w,
                                                 bf16_t* __restrict__ rqr, bf16_t* __restrict__ rkr,
                                                 bf16_t* __restrict__ cq, bf16_t* __restrict__ ck, bf16_t* __restrict__ cv) {
    const int t = blockIdx.x, tid = threadIdx.x;
    {
        const int which = tid >> 7, h = (tid >> 5) & 3, j = tid & 31;
        const bf16_t* p = projb + (size_t)t * NPROJ + which * 256 + h * 64;
        const float a = bf2f(p[j]), b = bf2f(p[j + 32]);
        double u = (double)t * INVREV[j];
        u -= rint(u);
        const float fr = (float)u;
        const float sn = __builtin_amdgcn_sinf(fr), cs = __builtin_amdgcn_cosf(fr);
        const float sc = which ? 0.125f : 1.f;
        bf16_t* o = (which ? rkr : rqr) + (size_t)t * 256 + h * 64;
        o[j] = f2bf((a * cs - b * sn) * sc);
        o[j + 32] = f2bf((a * sn + b * cs) * sc);
    }
    {
        const int h = tid >> 6, l = tid & 63;
        float vals[3][2];
#pragma unroll
        for (int part = 0; part < 3; ++part)
#pragma unroll
            for (int e = 0; e < 2; ++e) {
                const int c = part * 512 + h * 128 + 2 * l + e;
                float acc = 0.f;
#pragma unroll
                for (int j = 0; j < 4; ++j) {
                    const int tt = t - 3 + j;
                    if (tt >= 0) acc += conv_w[j * 1536 + c] * bf2f(projb[(size_t)tt * NPROJ + C_GQ + c]);
                }
                vals[part][e] = silu(acc);
            }
        const float sq = wave_sum(vals[0][0] * vals[0][0] + vals[0][1] * vals[0][1]);
        const float sk = wave_sum(vals[1][0] * vals[1][0] + vals[1][1] * vals[1][1]);
        const float rq = rsqrtf(sq + EPS), rk = rsqrtf(sk + EPS);
        const size_t o = (size_t)t * 512 + h * 128 + 2 * l;
        cq[o] = f2bf(vals[0][0] * rq); cq[o + 1] = f2bf(vals[0][1] * rq);
        ck[o] = f2bf(vals[1][0] * rk); ck[o + 1] = f2bf(vals[1][1] * rk);
        cv[o] = f2bf(vals[2][0]); cv[o + 1] = f2bf(vals[2][1]);
    }
}

__global__ __launch_bounds__(64) void k_recur_ret(const bf16_t* __restrict__ rqr, const bf16_t* __restrict__ rkr, const bf16_t* __restrict__ projb, float* __restrict__ o_r) {
    const int h = blockIdx.x >> 7, e = blockIdx.x & 127, lane = threadIdx.x;
    const float gamma = 1.f - exp2f(-5.f - (float)h);
    float s = 0.f;
    const bf16_t* qp = rqr + h * 64 + lane;
    const bf16_t* kp = rkr + h * 64 + lane;
    const bf16_t* vp = projb + C_RV + h * 128 + e;
    for (int t0 = 0; t0 < T_; t0 += 8) {
        float k[8], q[8], v[8];
#pragma unroll
        for (int i = 0; i < 8; ++i) {
            k[i] = bf2f(kp[(size_t)(t0 + i) * 256]);
            q[i] = bf2f(qp[(size_t)(t0 + i) * 256]);
            v[i] = bf2f(vp[(size_t)(t0 + i) * NPROJ]);
        }
#pragma unroll
        for (int i = 0; i < 8; ++i) {
            s = gamma * s + k[i] * v[i];
            const float p = wave_sum(q[i] * s);
            if (lane == 0) o_r[(size_t)(t0 + i) * 512 + h * 128 + e] = p;
        }
    }
}

__global__ __launch_bounds__(64) void k_recur_gdn(const bf16_t* __restrict__ cq, const bf16_t* __restrict__ ck, const bf16_t* __restrict__ cv,
                                                  const float* __restrict__ gdec, const float* __restrict__ beta, float* __restrict__ o_g) {
    const int h = blockIdx.x >> 7, e = blockIdx.x & 127, lane = threadIdx.x;
    float s0 = 0.f, s1 = 0.f;
    const bf16_t* qp = cq + h * 128 + 2 * lane;
    const bf16_t* kp = ck + h * 128 + 2 * lane;
    const bf16_t* vp = cv + h * 128 + e;
    for (int t0 = 0; t0 < T_; t0 += 8) {
        float k0[8], k1[8], q0[8], q1[8], v[8], a[8], b[8];
#pragma unroll
        for (int i = 0; i < 8; ++i) {
            const size_t t = t0 + i;
            k0[i] = bf2f(kp[t * 512]); k1[i] = bf2f(kp[t * 512 + 1]);
            q0[i] = bf2f(qp[t * 512]); q1[i] = bf2f(qp[t * 512 + 1]);
            v[i] = bf2f(vp[t * 512]);
            a[i] = __expf(gdec[t * 4 + h]);
            b[i] = beta[t * 4 + h];
        }
#pragma unroll
        for (int i = 0; i < 8; ++i) {
            const float ks = wave_sum(k0[i] * s0 + k1[i] * s1);
            const float coef = b[i] * (v[i] - a[i] * ks);
            s0 = a[i] * s0 + coef * k0[i];
            s1 = a[i] * s1 + coef * k1[i];
            const float o = wave_sum(q0[i] * s0 + q1[i] * s1) * 0.08838834764831845f;
            if (lane == 0) o_g[(size_t)(t0 + i) * 512 + h * 128 + e] = o;
        }
    }
}

__global__ __launch_bounds__(256) void k_mixnorm(const float* __restrict__ o_r, const float* __restrict__ o_g, const bf16_t* __restrict__ projb,
                                                 const float* __restrict__ ret_norm_w, const float* __restrict__ gdn_norm_w, bf16_t* __restrict__ mixed) {
    const int gw = blockIdx.x * 4 + (threadIdx.x >> 6), l = threadIdx.x & 63;
    const int t = gw >> 3, g = gw & 7;
    if (g < 4) {
        const float2 o = *(const float2*)(o_r + (size_t)t * 512 + g * 128 + 2 * l);
        const float mu = wave_sum(o.x + o.y) * (1.f / 128.f);
        const float d0 = o.x - mu, d1 = o.y - mu;
        const float var = wave_sum(d0 * d0 + d1 * d1) * (1.f / 128.f);
        const float rs = rsqrtf(var + EPS);
        const bf16_t* gp = projb + (size_t)t * NPROJ + C_RG + g * 128 + 2 * l;
        const float y0 = d0 * rs * ret_norm_w[g * 128 + 2 * l] * silu(bf2f(gp[0]));
        const float y1 = d1 * rs * ret_norm_w[g * 128 + 2 * l + 1] * silu(bf2f(gp[1]));
        bf16_t* mp = mixed + (size_t)t * 1024 + g * 128 + 2 * l;
        mp[0] = f2bf(y0); mp[1] = f2bf(y1);
    } else {
        const int h = g - 4;
        const float2 o = *(const float2*)(o_g + (size_t)t * 512 + h * 128 + 2 * l);
        const float ms = wave_sum(o.x * o.x + o.y * o.y) * (1.f / 128.f);
        const float rs = rsqrtf(ms + EPS);
        const bf16_t* gp = projb + (size_t)t * NPROJ + C_GZ + h * 128 + 2 * l;
        const float y0 = o.x * rs * gdn_norm_w[2 * l] * silu(bf2f(gp[0]));
        const float y1 = o.y * rs * gdn_norm_w[2 * l + 1] * silu(bf2f(gp[1]));
        bf16_t* mp = mixed + (size_t)t * 1024 + 512 + h * 128 + 2 * l;
        mp[0] = f2bf(y0); mp[1] = f2bf(y1);
    }
}

__global__ __launch_bounds__(256) void k_rownorm2(const float* __restrict__ x2, bf16_t* __restrict__ x2b, float* __restrict__ r2) {
    const int row = blockIdx.x * 4 + (threadIdx.x >> 6), lane = threadIdx.x & 63;
    float ss = 0.f;
#pragma unroll
    for (int j = 0; j < 4; ++j) {
        const int c = j * 256 + lane * 4;
        const float4 v = *(const float4*)(x2 + (size_t)row * 1024 + c);
        ss += v.x * v.x + v.y * v.y + v.z * v.z + v.w * v.w;
        ushort4 o; o.x = f2bf(v.x); o.y = f2bf(v.y); o.z = f2bf(v.z); o.w = f2bf(v.w);
        *(ushort4*)(x2b + (size_t)row * 1024 + c) = o;
    }
    ss = wave_sum(ss);
    if (lane == 0) r2[row] = rsqrtf(ss * (1.f / 1024.f) + EPS);
}

constexpr int SLD = 136;
__global__ __launch_bounds__(256) void k_scores_topk(const bf16_t* __restrict__ qp, const bf16_t* __restrict__ keysb, unsigned* __restrict__ top1) {
    __shared__ __attribute__((aligned(16))) unsigned char smem[2 * 128 * SLD * 2];
    bf16_t (*As)[SLD] = (bf16_t(*)[SLD])smem;
    bf16_t (*Bs)[SLD] = (bf16_t(*)[SLD])(smem + 128 * SLD * 2);
    unsigned (*S)[129] = (unsigned(*)[129])smem;
    const int tid = threadIdx.x, lane = tid & 63, w = tid >> 6;
    const int wr = w >> 1, wc = w & 1, r = lane & 15, quad = lane >> 4;
    const int hp = blockIdx.x & 15, t0 = (blockIdx.x >> 4) * 128;
#pragma unroll
    for (int j = 0; j < 8; ++j) {
        const int c = tid + 256 * j, row = c >> 4, cc = c & 15;
        *(uint4*)&As[row][cc * 8] = *(const uint4*)(qp + (size_t)(t0 + row) * 2048 + hp * 128 + cc * 8);
        *(uint4*)&Bs[row][cc * 8] = *(const uint4*)(keysb + (size_t)hp * 16384 + row * 128 + cc * 8);
    }
    __syncthreads();
    f32x4 acc[4][4];
#pragma unroll
    for (int i = 0; i < 4; ++i)
#pragma unroll
        for (int j = 0; j < 4; ++j) acc[i][j] = (f32x4){0.f, 0.f, 0.f, 0.f};
#pragma unroll
    for (int ks = 0; ks < 4; ++ks) {
        bf16x8 a[4], b[4];
#pragma unroll
        for (int i = 0; i < 4; ++i) a[i] = *(const bf16x8*)&As[wr * 64 + i * 16 + r][ks * 32 + quad * 8];
#pragma unroll
        for (int j = 0; j < 4; ++j) b[j] = *(const bf16x8*)&Bs[wc * 64 + j * 16 + r][ks * 32 + quad * 8];
#pragma unroll
        for (int i = 0; i < 4; ++i)
#pragma unroll
            for (int j = 0; j < 4; ++j) acc[i][j] = __builtin_amdgcn_mfma_f32_16x16x32_bf16(b[j], a[i], acc[i][j], 0, 0, 0);
    }
    __syncthreads();
#pragma unroll
    for (int i = 0; i < 4; ++i)
#pragma unroll
        for (int j = 0; j < 4; ++j)
#pragma unroll
            for (int v = 0; v < 4; ++v) {
                const int row = wr * 64 + i * 16 + r, col = wc * 64 + j * 16 + quad * 4 + v;
                S[row][col] = (fkey(acc[i][j][v]) & ~0x7Fu) | (unsigned)col;
            }
    __syncthreads();
    if (tid < 128) {
        unsigned top[16];
#pragma unroll
        for (int i = 0; i < 16; ++i) top[i] = 0u;
        for (int c = 0; c < 128; ++c) {
            const unsigned v = S[tid][c];
            if (v > top[15]) {
                top[15] = v;
#pragma unroll
                for (int i = 15; i > 0; --i) {
                    const unsigned hi = max(top[i - 1], top[i]), lo = min(top[i - 1], top[i]);
                    top[i - 1] = hi; top[i] = lo;
                }
            }
        }
        unsigned* o = top1 + ((size_t)(t0 + tid) * 16 + hp) * 16;
#pragma unroll
        for (int i = 0; i < 4; ++i) *(uint4*)(o + 4 * i) = make_uint4(top[4 * i], top[4 * i + 1], top[4 * i + 2], top[4 * i + 3]);
    }
}

__global__ __launch_bounds__(256) void k_cand(const unsigned* __restrict__ top1, int* __restrict__ sel_id, float* __restrict__ sel_g) {
    const int gid = blockIdx.x * 256 + threadIdx.x;
    const int t = gid >> 3, h = gid & 7;
    const unsigned* p0 = top1 + ((size_t)t * 16 + h * 2) * 16;
    const unsigned* p1 = p0 + 16;
    float s1[16], s2[16];
#pragma unroll
    for (int i = 0; i < 4; ++i) {
        const uint4 a = *(const uint4*)(p0 + 4 * i), b = *(const uint4*)(p1 + 4 * i);
        s1[4 * i] = keyf(a.x & ~0x7Fu); s1[4 * i + 1] = keyf(a.y & ~0x7Fu); s1[4 * i + 2] = keyf(a.z & ~0x7Fu); s1[4 * i + 3] = keyf(a.w & ~0x7Fu);
        s2[4 * i] = keyf(b.x & ~0x7Fu); s2[4 * i + 1] = keyf(b.y & ~0x7Fu); s2[4 * i + 2] = keyf(b.z & ~0x7Fu); s2[4 * i + 3] = keyf(b.w & ~0x7Fu);
    }
    unsigned top[16];
#pragma unroll
    for (int i = 0; i < 16; ++i) top[i] = 0u;
#pragma unroll
    for (int a = 0; a < 16; ++a)
#pragma unroll
        for (int b = 0; b < 16; ++b)
            if ((a + 1) * (b + 1) <= 16) {
                const unsigned v = (fkey(s1[a] + s2[b]) & ~0xFFu) | (unsigned)(a * 16 + b);
                if (v > top[15]) {
                    top[15] = v;
#pragma unroll
                    for (int i = 15; i > 0; --i) {
                        const unsigned hi = max(top[i - 1], top[i]), lo = min(top[i - 1], top[i]);
                        top[i - 1] = hi; top[i] = lo;
                    }
                }
            }
    float ex[16], sum = 0.f;
    const float m = keyf(top[0] & ~0xFFu);
#pragma unroll
    for (int i = 0; i < 16; ++i) { ex[i] = __expf(keyf(top[i] & ~0xFFu) - m); sum += ex[i]; }
    const float inv = 1.f / sum;
#pragma unroll
    for (int i = 0; i < 16; ++i) {
        const int ab = top[i] & 0xFF;
        const int i1 = p0[ab >> 4] & 0x7F, i2 = p1[ab & 15] & 0x7F;
        sel_id[(size_t)t * 128 + h * 16 + i] = i1 * 128 + i2;
        sel_g[(size_t)t * 128 + h * 16 + i] = ex[i] * inv;
    }
}

__global__ __launch_bounds__(256) void k_peer(const float* x2, const float* __restrict__ r2, const float* __restrict__ ln2_w,
                                              const int* __restrict__ sel_id, const float* __restrict__ sel_g,
                                              const float* __restrict__ peer_u, const float* __restrict__ peer_v, const float* __restrict__ lnf_w,
                                              float* out) {
    const int t = blockIdx.x * 4 + (threadIdx.x >> 6), lane = threadIdx.x & 63;
    float4 xv[4], h2[4], acc[4];
    const float rr = r2[t];
#pragma unroll
    for (int j = 0; j < 4; ++j) {
        const int c = j * 256 + lane * 4;
        xv[j] = *(const float4*)(x2 + (size_t)t * 1024 + c);
        const float4 w = *(const float4*)(ln2_w + c);
        h2[j] = make_float4(xv[j].x * rr * w.x, xv[j].y * rr * w.y, xv[j].z * rr * w.z, xv[j].w * rr * w.w);
        acc[j] = make_float4(0.f, 0.f, 0.f, 0.f);
    }
    const int id0 = sel_id[(size_t)t * 128 + lane], id1 = sel_id[(size_t)t * 128 + 64 + lane];
    const float gg0 = sel_g[(size_t)t * 128 + lane], gg1 = sel_g[(size_t)t * 128 + 64 + lane];
    for (int half = 0; half < 2; ++half) {
        const int idv = half ? id1 : id0;
        const float gv = half ? gg1 : gg0;
#pragma unroll 4
        for (int k = 0; k < 64; ++k) {
            const int id = __builtin_amdgcn_readlane(idv, k);
            const float gate = __uint_as_float(__builtin_amdgcn_readlane(__float_as_uint(gv), k));
            const float* ur = peer_u + (size_t)id * 1024 + lane * 4;
            float d = 0.f;
#pragma unroll
            for (int j = 0; j < 4; ++j) {
                const float4 u4 = *(const float4*)(ur + 256 * j);
                d += u4.x * h2[j].x + u4.y * h2[j].y + u4.z * h2[j].z + u4.w * h2[j].w;
            }
            d = wave_sum(d);
            const float c = gate * 0.5f * d * (1.f + erff(d * 0.70710678118654752f));
            const float* vr = peer_v + (size_t)id * 1024 + lane * 4;
#pragma unroll
            for (int j = 0; j < 4; ++j) {
                const float4 v4 = *(const float4*)(vr + 256 * j);
                acc[j].x += c * v4.x; acc[j].y += c * v4.y; acc[j].z += c * v4.z; acc[j].w += c * v4.w;
            }
        }
    }
    float ss = 0.f;
#pragma unroll
    for (int j = 0; j < 4; ++j) {
        acc[j].x += xv[j].x; acc[j].y += xv[j].y; acc[j].z += xv[j].z; acc[j].w += xv[j].w;
        ss += acc[j].x * acc[j].x + acc[j].y * acc[j].y + acc[j].z * acc[j].z + acc[j].w * acc[j].w;
    }
    ss = wave_sum(ss);
    const float rs = rsqrtf(ss * (1.f / 1024.f) + EPS);
#pragma unroll
    for (int j = 0; j < 4; ++j) {
        const int c = j * 256 + lane * 4;
        const float4 w = *(const float4*)(lnf_w + c);
        *(float4*)(out + (size_t)t * 1024 + c) = make_float4(acc[j].x * rs * w.x, acc[j].y * rs * w.y, acc[j].z * rs * w.z, acc[j].w * rs * w.w);
    }
}

extern "C" void kernel_launch(void* const* d_in, const int* in_sizes, int n_in, void* d_out, int out_size, void* d_ws, size_t ws_size, hipStream_t stream) {
    const float* x = (const float*)d_in[0];
    const float* ln1_w = (const float*)d_in[1];
    const float* w_in = (const float*)d_in[2];
    const float* ret_norm_w = (const float*)d_in[3];
    const float* conv_w = (const float*)d_in[4];
    const float* A_log = (const float*)d_in[5];
    const float* dt_bias = (const float*)d_in[6];
    const float* gdn_norm_w = (const float*)d_in[7];
    const float* w_out = (const float*)d_in[8];
    const float* ln2_w = (const float*)d_in[9];
    const float* peer_wq = (const float*)d_in[10];
    const float* peer_keys = (const float*)d_in[11];
    const float* peer_u = (const float*)d_in[12];
    const float* peer_v = (const float*)d_in[13];
    const float* lnf_w = (const float*)d_in[14];
    float* out = (float*)d_out;
    unsigned char* ws = (unsigned char*)d_ws;
    constexpr size_t MiB = 1024 * 1024;
    size_t off = 0;
    bf16_t* WinT = (bf16_t*)(ws + off); off += (size_t)NPROJ * 1024 * 2;
    bf16_t* WoutT = (bf16_t*)(ws + off); off += (size_t)1024 * 1024 * 2;
    bf16_t* WqT = (bf16_t*)(ws + off); off += (size_t)2048 * 1024 * 2;
    bf16_t* keysb = (bf16_t*)(ws + off); off += (size_t)16 * 128 * 128 * 2;
    float* r1 = (float*)(ws + off); off += 65536;
    float* r2 = (float*)(ws + off); off += 65536;
    float* gdec = (float*)(ws + off); off += 262144;
    float* beta = (float*)(ws + off); off += 262144;
    off = (off + MiB - 1) / MiB * MiB;
    bf16_t* xb = (bf16_t*)(ws + off); bf16_t* x2b = xb; off += 32 * MiB;
    bf16_t* projb = (bf16_t*)(ws + off);
    bf16_t* qp = projb;
    unsigned* top1 = (unsigned*)(ws + off + 64 * MiB);
    int* sel_id = (int*)(ws + off + 80 * MiB);
    float* sel_g = (float*)(ws + off + 88 * MiB);
    off += 112 * MiB;
    bf16_t* cq = (bf16_t*)(ws + off); bf16_t* mixed = cq;
    bf16_t* ck = (bf16_t*)(ws + off + 16 * MiB);
    bf16_t* cv = (bf16_t*)(ws + off + 32 * MiB);
    bf16_t* rqr = (bf16_t*)(ws + off + 48 * MiB);
    bf16_t* rkr = (bf16_t*)(ws + off + 56 * MiB);
    off += 64 * MiB;
    float* o_r = out;
    float* o_g = out + (size_t)T_ * 512;
    if (ws_size < off) return;

    k_prep_x<<<T_ / 4, 256, 0, stream>>>(x, ln1_w, w_in, A_log, dt_bias, xb, r1, gdec, beta);
    k_transpose<<<dim3(NPROJ / 32, 32), 256, 0, stream>>>(w_in, LDWIN, ln1_w, WinT, 1024);
    k_transpose<<<dim3(1024 / 32, 32), 256, 0, stream>>>(w_out, 1024, nullptr, WoutT, 1024);
    k_transpose<<<dim3(2048 / 32, 32), 256, 0, stream>>>(peer_wq, 2048, ln2_w, WqT, 1024);
    k_convert<<<(16 * 128 * 128 / 4) / 256, 256, 0, stream>>>(peer_keys, keysb, 16 * 128 * 128 / 4);
    k_gemm<0><<<(T_ / 128) * (NPROJ / 128), 256, 0, stream>>>(xb, 1024, WinT, 1024, 1024, projb, NPROJ, r1, NPROJ / 128);
    k_preproc<<<T_, 256, 0, stream>>>(projb, conv_w, rqr, rkr, cq, ck, cv);
    k_recur_ret<<<512, 64, 0, stream>>>(rqr, rkr, projb, o_r);
    k_recur_gdn<<<512, 64, 0, stream>>>(cq, ck, cv, gdec, beta, o_g);
    k_mixnorm<<<T_ * 8 / 4, 256, 0, stream>>>(o_r, o_g, projb, ret_norm_w, gdn_norm_w, mixed);
    k_gemm<1><<<(T_ / 128) * (1024 / 128), 256, 0, stream>>>(mixed, 1024, WoutT, 1024, 1024, out, 1024, x, 1024 / 128);
    k_rownorm2<<<T_ / 4, 256, 0, stream>>>(out, x2b, r2);
    k_gemm<0><<<(T_ / 128) * (2048 / 128), 256, 0, stream>>>(x2b, 1024, WqT, 1024, 1024, qp, 2048, r2, 2048 / 128);
    k_scores_topk<<<(T_ / 128) * 16, 256, 0, stream>>>(qp, keysb, top1);
    k_cand<<<T_ * 8 / 256, 256, 0, stream>>>(top1, sel_id, sel_g);
    k_peer<<<T_ / 4, 256, 0, stream>>>(out, r2, ln2_w, sel_id, sel_g, peer_u, peer_v, lnf_w, out);
}
```

```cpp
#include <hip/hip_runtime.h>
#include <hip/hip_cooperative_groups.h>
#include <stdint.h>
#include <cstdio>
namespace cg = cooperative_groups;

typedef unsigned short bf16_t;
typedef __attribute__((ext_vector_type(8))) short bf16x8;
typedef __attribute__((ext_vector_type(4))) float f32x4;

constexpr int T_ = 16384;
constexpr int NPROJ = 3584;
constexpr int LDWIN = 3592;
constexpr float EPS = 1e-6f;

constexpr int C_RQ = 0, C_RK = 256, C_RV = 512, C_RG = 1024, C_GQ = 1536, C_GK = 2048, C_GV = 2560, C_GZ = 3072;

__constant__ double INVREV[32] = {0.15915494309189535, 0.11934937021124886, 0.08949940160889101, 0.06711508300522726, 0.050329212104487035, 0.03774158471741977, 0.0283021958306234, 0.02122365276477766, 0.015915494309189534, 0.011934937021124886, 0.0089499401608891, 0.006711508300522725, 0.005032921210448704, 0.003774158471741977, 0.00283021958306234, 0.002122365276477766, 0.0015915494309189536, 0.0011934937021124887, 0.0008949940160889102, 0.0006711508300522725, 0.0005032921210448703, 0.0003774158471741977, 0.00028302195830623395, 0.00021223652764777658, 0.00015915494309189535, 0.00011934937021124886, 8.9499401608891e-05, 6.711508300522725e-05, 5.0329212104487035e-05, 3.774158471741978e-05, 2.83021958306234e-05, 2.122365276477766e-05};

__device__ __forceinline__ bf16_t f2bf(float f) {
    unsigned u = __float_as_uint(f);
    u += 0x7fffu + ((u >> 16) & 1u);
    return (bf16_t)(u >> 16);
}
__device__ __forceinline__ float bf2f(bf16_t h) { return __uint_as_float(((unsigned)h) << 16); }
__device__ __forceinline__ float wave_sum(float v) {
#pragma unroll
    for (int o = 32; o > 0; o >>= 1) v += __shfl_xor(v, o);
    return v;
}
__device__ __forceinline__ float silu(float x) { return x / (1.f + __expf(-x)); }
__device__ __forceinline__ unsigned fkey(float f) { unsigned u = __float_as_uint(f); return (u & 0x80000000u) ? ~u : (u | 0x80000000u); }
__device__ __forceinline__ float keyf(unsigned k) { return __uint_as_float((k & 0x80000000u) ? (k & 0x7fffffffu) : ~k); }

__device__ __forceinline__ void k_prep_x(int bid, const float* __restrict__ x, const float* __restrict__ ln1_w, const float* __restrict__ w_in,
                                                const float* __restrict__ A_log, const float* __restrict__ dt_bias,
                                                bf16_t* __restrict__ xb, float* __restrict__ r1, float* __restrict__ gdec, float* __restrict__ beta) {
    const int wave = threadIdx.x >> 6, lane = threadIdx.x & 63;
    const int row = bid * 4 + wave;
    const float* xr = x + (size_t)row * 1024;
    float ss = 0.f;
    float g0 = 0, g1 = 0, g2 = 0, g3 = 0, g4 = 0, g5 = 0, g6 = 0, g7 = 0;
#pragma unroll
    for (int j = 0; j < 4; ++j) {
        const int c = j * 256 + lane * 4;
        const float4 v = *(const float4*)(xr + c);
        const float4 w = *(const float4*)(ln1_w + c);
        ss += v.x * v.x + v.y * v.y + v.z * v.z + v.w * v.w;
        ushort4 o; o.x = f2bf(v.x); o.y = f2bf(v.y); o.z = f2bf(v.z); o.w = f2bf(v.w);
        *(ushort4*)(xb + (size_t)row * 1024 + c) = o;
        const float xs[4] = {v.x * w.x, v.y * w.y, v.z * w.z, v.w * w.w};
#pragma unroll
        for (int e = 0; e < 4; ++e) {
            const float* wp = w_in + (size_t)(c + e) * LDWIN + NPROJ;
            const float4 a = *(const float4*)wp; const float4 b = *(const float4*)(wp + 4);
            g0 += xs[e] * a.x; g1 += xs[e] * a.y; g2 += xs[e] * a.z; g3 += xs[e] * a.w;
            g4 += xs[e] * b.x; g5 += xs[e] * b.y; g6 += xs[e] * b.z; g7 += xs[e] * b.w;
        }
    }
    ss = wave_sum(ss);
    g0 = wave_sum(g0); g1 = wave_sum(g1); g2 = wave_sum(g2); g3 = wave_sum(g3);
    g4 = wave_sum(g4); g5 = wave_sum(g5); g6 = wave_sum(g6); g7 = wave_sum(g7);
    const float r = rsqrtf(ss * (1.f / 1024.f) + EPS);
    if (lane == 0) {
        r1[row] = r;
        const float ga[4] = {g0 * r, g1 * r, g2 * r, g3 * r};
        const float gb[4] = {g4 * r, g5 * r, g6 * r, g7 * r};
#pragma unroll
        for (int h = 0; h < 4; ++h) {
            const float xx = ga[h] + dt_bias[h];
            const float sp = xx > 20.f ? xx : log1pf(expf(xx));
            gdec[row * 4 + h] = -expf(A_log[h]) * sp;
            beta[row * 4 + h] = 1.f / (1.f + expf(-gb[h]));
        }
    }
}

__device__ __forceinline__ void k_transpose(int bidx, int bidy, float (*tile)[33], const float* __restrict__ src, int ld, const float* __restrict__ scale, bf16_t* __restrict__ dst, int K) {
    const int n0 = bidx * 32, k0 = bidy * 32;
    const int tx = threadIdx.x & 31, ty = threadIdx.x >> 5;
#pragma unroll
    for (int j = 0; j < 4; ++j) {
        const int k = k0 + ty + 8 * j;
        const float s = scale ? scale[k] : 1.f;
        tile[ty + 8 * j][tx] = src[(size_t)k * ld + n0 + tx] * s;
    }
    __syncthreads();
#pragma unroll
    for (int j = 0; j < 4; ++j) {
        const int n = n0 + ty + 8 * j;
        dst[(size_t)n * K + k0 + tx] = f2bf(tile[tx][ty + 8 * j]);
    }
    __syncthreads();
}

__device__ __forceinline__ void k_convert(int bid, const float* __restrict__ src, bf16_t* __restrict__ dst, int n4) {
    const int i = bid * 256 + threadIdx.x;
    if (i < n4) {
        const float4 v = ((const float4*)src)[i];
        ushort4 o; o.x = f2bf(v.x); o.y = f2bf(v.y); o.z = f2bf(v.z); o.w = f2bf(v.w);
        ((ushort4*)dst)[i] = o;
    }
}

constexpr int GLD = 72;
template <int EPI>
__device__ __forceinline__ void k_gemm(int bid, unsigned char* smem, const bf16_t* __restrict__ A, int lda, const bf16_t* __restrict__ Bt, int ldb, int K,
                                              void* __restrict__ Cv, int ldc, const float* __restrict__ aux, int ntn) {
    bf16_t (*As)[128][GLD] = (bf16_t(*)[128][GLD])smem;
    bf16_t (*Bs)[128][GLD] = (bf16_t(*)[128][GLD])(smem + 2 * 128 * GLD * 2);
    const int tid = threadIdx.x, lane = tid & 63, w = tid >> 6;
    const int wr = w >> 1, wc = w & 1, r = lane & 15, quad = lane >> 4;
    const int tm = bid / ntn, tn = bid % ntn;
    const int m0 = tm * 128, n0 = tn * 128;
    const bf16_t* Ag = A + (size_t)m0 * lda;
    const bf16_t* Bg = Bt + (size_t)n0 * ldb;
    f32x4 acc[4][4];
#pragma unroll
    for (int i = 0; i < 4; ++i)
#pragma unroll
        for (int j = 0; j < 4; ++j) acc[i][j] = (f32x4){0.f, 0.f, 0.f, 0.f};
    uint4 ra[4], rb[4];
    const int nk = K / 64;
#pragma unroll
    for (int j = 0; j < 4; ++j) {
        const int c = tid + 256 * j, row = c >> 3, cc = c & 7;
        ra[j] = *(const uint4*)(Ag + (size_t)row * lda + cc * 8);
        rb[j] = *(const uint4*)(Bg + (size_t)row * ldb + cc * 8);
    }
#pragma unroll
    for (int j = 0; j < 4; ++j) {
        const int c = tid + 256 * j, row = c >> 3, cc = c & 7;
        *(uint4*)&As[0][row][cc * 8] = ra[j];
        *(uint4*)&Bs[0][row][cc * 8] = rb[j];
    }
    __syncthreads();
    for (int kt = 0; kt < nk; ++kt) {
        const int buf = kt & 1;
        const int kn = (kt + 1 < nk) ? kt + 1 : kt;
#pragma unroll
        for (int j = 0; j < 4; ++j) {
            const int c = tid + 256 * j, row = c >> 3, cc = c & 7;
            ra[j] = *(const uint4*)(Ag + (size_t)row * lda + kn * 64 + cc * 8);
            rb[j] = *(const uint4*)(Bg + (size_t)row * ldb + kn * 64 + cc * 8);
        }
        const bf16_t (*Ab)[GLD] = As[buf];
        const bf16_t (*Bb)[GLD] = Bs[buf];
#pragma unroll
        for (int ks = 0; ks < 2; ++ks) {
            bf16x8 a[4], b[4];
#pragma unroll
            for (int i = 0; i < 4; ++i) a[i] = *(const bf16x8*)&Ab[wr * 64 + i * 16 + r][ks * 32 + quad * 8];
#pragma unroll
            for (int j = 0; j < 4; ++j) b[j] = *(const bf16x8*)&Bb[wc * 64 + j * 16 + r][ks * 32 + quad * 8];
#pragma unroll
            for (int i = 0; i < 4; ++i)
#pragma unroll
                for (int j = 0; j < 4; ++j) acc[i][j] = __builtin_amdgcn_mfma_f32_16x16x32_bf16(b[j], a[i], acc[i][j], 0, 0, 0);
        }
        bf16_t (*An)[GLD] = As[buf ^ 1];
        bf16_t (*Bn)[GLD] = Bs[buf ^ 1];
#pragma unroll
        for (int j = 0; j < 4; ++j) {
            const int c = tid + 256 * j, row = c >> 3, cc = c & 7;
            *(uint4*)&An[row][cc * 8] = ra[j];
            *(uint4*)&Bn[row][cc * 8] = rb[j];
        }
        __syncthreads();
    }
#pragma unroll
    for (int i = 0; i < 4; ++i) {
        const int row = m0 + wr * 64 + i * 16 + r;
        float rs = 1.f;
        if (EPI == 0) rs = aux[row];
#pragma unroll
        for (int j = 0; j < 4; ++j) {
            const int col = n0 + wc * 64 + j * 16 + quad * 4;
            if (EPI == 0) {
                ushort4 o; o.x = f2bf(acc[i][j][0] * rs); o.y = f2bf(acc[i][j][1] * rs); o.z = f2bf(acc[i][j][2] * rs); o.w = f2bf(acc[i][j][3] * rs);
                *(ushort4*)((bf16_t*)Cv + (size_t)row * ldc + col) = o;
            } else {
                const float4 xr = *(const float4*)(aux + (size_t)row * ldc + col);
                float4 o; o.x = xr.x + acc[i][j][0]; o.y = xr.y + acc[i][j][1]; o.z = xr.z + acc[i][j][2]; o.w = xr.w + acc[i][j][3];
                *(float4*)((float*)Cv + (size_t)row * ldc + col) = o;
            }
        }
    }
}

__device__ __forceinline__ void k_preproc(int bid, const bf16_t* __restrict__ projb, const float* __restrict__ conv_w,
                                                 bf16_t* __restrict__ rqr, bf16_t* __restrict__ rkr,
                                                 bf16_t* __restrict__ cq, bf16_t* __restrict__ ck, bf16_t* __restrict__ cv) {
    const int t = bid, tid = threadIdx.x;
    {
        const int which = tid >> 7, h = (tid >> 5) & 3, j = tid & 31;
        const bf16_t* p = projb + (size_t)t * NPROJ + which * 256 + h * 64;
        const float a = bf2f(p[j]), b = bf2f(p[j + 32]);
        double u = (double)t * INVREV[j];
        u -= rint(u);
        const float fr = (float)u;
        const float sn = __builtin_amdgcn_sinf(fr), cs = __builtin_amdgcn_cosf(fr);
        const float sc = which ? 0.125f : 1.f;
        bf16_t* o = (which ? rkr : rqr) + (size_t)t * 256 + h * 64;
        o[j] = f2bf((a * cs - b * sn) * sc);
        o[j + 32] = f2bf((a * sn + b * cs) * sc);
    }
    {
        const int h = tid >> 6, l = tid & 63;
        float vals[3][2];
#pragma unroll
        for (int part = 0; part < 3; ++part)
#pragma unroll
            for (int e = 0; e < 2; ++e) {
                const int c = part * 512 + h * 128 + 2 * l + e;
                float acc = 0.f;
#pragma unroll
                for (int j = 0; j < 4; ++j) {
                    const int tt = t - 3 + j;
                    if (tt >= 0) acc += conv_w[j * 1536 + c] * bf2f(projb[(size_t)tt * NPROJ + C_GQ + c]);
                }
                vals[part][e] = silu(acc);
            }
        const float sq = wave_sum(vals[0][0] * vals[0][0] + vals[0][1] * vals[0][1]);
        const float sk = wave_sum(vals[1][0] * vals[1][0] + vals[1][1] * vals[1][1]);
        const float rq = rsqrtf(sq + EPS), rk = rsqrtf(sk + EPS);
        const size_t o = (size_t)t * 512 + h * 128 + 2 * l;
        cq[o] = f2bf(vals[0][0] * rq); cq[o + 1] = f2bf(vals[0][1] * rq);
        ck[o] = f2bf(vals[1][0] * rk); ck[o + 1] = f2bf(vals[1][1] * rk);
        cv[o] = f2bf(vals[2][0]); cv[o + 1] = f2bf(vals[2][1]);
    }
}

__device__ __forceinline__ void k_recur_ret(int bid, const bf16_t* __restrict__ rqr, const bf16_t* __restrict__ rkr, const bf16_t* __restrict__ projb, float* __restrict__ o_r) {
    const int h = bid >> 7, e = bid & 127, lane = threadIdx.x & 63;
    const float gamma = 1.f - exp2f(-5.f - (float)h);
    float s = 0.f;
    const bf16_t* qp = rqr + h * 64 + lane;
    const bf16_t* kp = rkr + h * 64 + lane;
    const bf16_t* vp = projb + C_RV + h * 128 + e;
    for (int t0 = 0; t0 < T_; t0 += 8) {
        float k[8], q[8], v[8];
#pragma unroll
        for (int i = 0; i < 8; ++i) {
            k[i] = bf2f(kp[(size_t)(t0 + i) * 256]);
            q[i] = bf2f(qp[(size_t)(t0 + i) * 256]);
            v[i] = bf2f(vp[(size_t)(t0 + i) * NPROJ]);
        }
#pragma unroll
        for (int i = 0; i < 8; ++i) {
            s = gamma * s + k[i] * v[i];
            const float p = wave_sum(q[i] * s);
            if (lane == 0) o_r[(size_t)(t0 + i) * 512 + h * 128 + e] = p;
        }
    }
}

__device__ __forceinline__ void k_recur_gdn(int bid, const bf16_t* __restrict__ cq, const bf16_t* __restrict__ ck, const bf16_t* __restrict__ cv,
                                                  const float* __restrict__ gdec, const float* __restrict__ beta, float* __restrict__ o_g) {
    const int h = bid >> 7, e = bid & 127, lane = threadIdx.x & 63;
    float s0 = 0.f, s1 = 0.f;
    const bf16_t* qp = cq + h * 128 + 2 * lane;
    const bf16_t* kp = ck + h * 128 + 2 * lane;
    const bf16_t* vp = cv + h * 128 + e;
    for (int t0 = 0; t0 < T_; t0 += 8) {
        float k0[8], k1[8], q0[8], q1[8], v[8], a[8], b[8];
#pragma unroll
        for (int i = 0; i < 8; ++i) {
            const size_t t = t0 + i;
            k0[i] = bf2f(kp[t * 512]); k1[i] = bf2f(kp[t * 512 + 1]);
            q0[i] = bf2f(qp[t * 512]); q1[i] = bf2f(qp[t * 512 + 1]);
            v[i] = bf2f(vp[t * 512]);
            a[i] = __expf(gdec[t * 4 + h]);
            b[i] = beta[t * 4 + h];
        }
#pragma unroll
        for (int i = 0; i < 8; ++i) {
            const float ks = wave_sum(k0[i] * s0 + k1[i] * s1);
            const float coef = b[i] * (v[i] - a[i] * ks);
            s0 = a[i] * s0 + coef * k0[i];
            s1 = a[i] * s1 + coef * k1[i];
            const float o = wave_sum(q0[i] * s0 + q1[i] * s1) * 0.08838834764831845f;
            if (lane == 0) o_g[(size_t)(t0 + i) * 512 + h * 128 + e] = o;
        }
    }
}

__device__ __forceinline__ void k_mixnorm(int bid, const float* __restrict__ o_r, const float* __restrict__ o_g, const bf16_t* __restrict__ projb,
                                                 const float* __restrict__ ret_norm_w, const float* __restrict__ gdn_norm_w, bf16_t* __restrict__ mixed) {
    const int gw = bid * 4 + (threadIdx.x >> 6), l = threadIdx.x & 63;
    const int t = gw >> 3, g = gw & 7;
    if (g < 4) {
        const float2 o = *(const float2*)(o_r + (size_t)t * 512 + g * 128 + 2 * l);
        const float mu = wave_sum(o.x + o.y) * (1.f / 128.f);
        const float d0 = o.x - mu, d1 = o.y - mu;
        const float var = wave_sum(d0 * d0 + d1 * d1) * (1.f / 128.f);
        const float rs = rsqrtf(var + EPS);
        const bf16_t* gp = projb + (size_t)t * NPROJ + C_RG + g * 128 + 2 * l;
        const float y0 = d0 * rs * ret_norm_w[g * 128 + 2 * l] * silu(bf2f(gp[0]));
        const float y1 = d1 * rs * ret_norm_w[g * 128 + 2 * l + 1] * silu(bf2f(gp[1]));
        bf16_t* mp = mixed + (size_t)t * 1024 + g * 128 + 2 * l;
        mp[0] = f2bf(y0); mp[1] = f2bf(y1);
    } else {
        const int h = g - 4;
        const float2 o = *(const float2*)(o_g + (size_t)t * 512 + h * 128 + 2 * l);
        const float ms = wave_sum(o.x * o.x + o.y * o.y) * (1.f / 128.f);
        const float rs = rsqrtf(ms + EPS);
        const bf16_t* gp = projb + (size_t)t * NPROJ + C_GZ + h * 128 + 2 * l;
        const float y0 = o.x * rs * gdn_norm_w[2 * l] * silu(bf2f(gp[0]));
        const float y1 = o.y * rs * gdn_norm_w[2 * l + 1] * silu(bf2f(gp[1]));
        bf16_t* mp = mixed + (size_t)t * 1024 + 512 + h * 128 + 2 * l;
        mp[0] = f2bf(y0); mp[1] = f2bf(y1);
    }
}

__device__ __forceinline__ void k_rownorm2(int bid, const float* __restrict__ x2, bf16_t* __restrict__ x2b, float* __restrict__ r2) {
    const int row = bid * 4 + (threadIdx.x >> 6), lane = threadIdx.x & 63;
    float ss = 0.f;
#pragma unroll
    for (int j = 0; j < 4; ++j) {
        const int c = j * 256 + lane * 4;
        const float4 v = *(const float4*)(x2 + (size_t)row * 1024 + c);
        ss += v.x * v.x + v.y * v.y + v.z * v.z + v.w * v.w;
        ushort4 o; o.x = f2bf(v.x); o.y = f2bf(v.y); o.z = f2bf(v.z); o.w = f2bf(v.w);
        *(ushort4*)(x2b + (size_t)row * 1024 + c) = o;
    }
    ss = wave_sum(ss);
    if (lane == 0) r2[row] = rsqrtf(ss * (1.f / 1024.f) + EPS);
}

constexpr int SLD = 136;
__device__ __forceinline__ void k_scores_topk(int bid, unsigned char* smem, const bf16_t* __restrict__ qp, const bf16_t* __restrict__ keysb, unsigned* __restrict__ top1) {
    bf16_t (*As)[SLD] = (bf16_t(*)[SLD])smem;
    bf16_t (*Bs)[SLD] = (bf16_t(*)[SLD])(smem + 128 * SLD * 2);
    unsigned (*S)[129] = (unsigned(*)[129])smem;
    const int tid = threadIdx.x, lane = tid & 63, w = tid >> 6;
    const int wr = w >> 1, wc = w & 1, r = lane & 15, quad = lane >> 4;
    const int hp = bid & 15, t0 = (bid >> 4) * 128;
#pragma unroll
    for (int j = 0; j < 8; ++j) {
        const int c = tid + 256 * j, row = c >> 4, cc = c & 15;
        *(uint4*)&As[row][cc * 8] = *(const uint4*)(qp + (size_t)(t0 + row) * 2048 + hp * 128 + cc * 8);
        *(uint4*)&Bs[row][cc * 8] = *(const uint4*)(keysb + (size_t)hp * 16384 + row * 128 + cc * 8);
    }
    __syncthreads();
    f32x4 acc[4][4];
#pragma unroll
    for (int i = 0; i < 4; ++i)
#pragma unroll
        for (int j = 0; j < 4; ++j) acc[i][j] = (f32x4){0.f, 0.f, 0.f, 0.f};
#pragma unroll
    for (int ks = 0; ks < 4; ++ks) {
        bf16x8 a[4], b[4];
#pragma unroll
        for (int i = 0; i < 4; ++i) a[i] = *(const bf16x8*)&As[wr * 64 + i * 16 + r][ks * 32 + quad * 8];
#pragma unroll
        for (int j = 0; j < 4; ++j) b[j] = *(const bf16x8*)&Bs[wc * 64 + j * 16 + r][ks * 32 + quad * 8];
#pragma unroll
        for (int i = 0; i < 4; ++i)
#pragma unroll
            for (int j = 0; j < 4; ++j) acc[i][j] = __builtin_amdgcn_mfma_f32_16x16x32_bf16(b[j], a[i], acc[i][j], 0, 0, 0);
    }
    __syncthreads();
#pragma unroll
    for (int i = 0; i < 4; ++i)
#pragma unroll
        for (int j = 0; j < 4; ++j)
#pragma unroll
            for (int v = 0; v < 4; ++v) {
                const int row = wr * 64 + i * 16 + r, col = wc * 64 + j * 16 + quad * 4 + v;
                S[row][col] = (fkey(acc[i][j][v]) & ~0x7Fu) | (unsigned)col;
            }
    __syncthreads();
    if (tid < 128) {
        unsigned top[16];
#pragma unroll
        for (int i = 0; i < 16; ++i) top[i] = 0u;
        for (int c = 0; c < 128; ++c) {
            const unsigned v = S[tid][c];
            if (v > top[15]) {
                top[15] = v;
#pragma unroll
                for (int i = 15; i > 0; --i) {
                    const unsigned hi = max(top[i - 1], top[i]), lo = min(top[i - 1], top[i]);
                    top[i - 1] = hi; top[i] = lo;
                }
            }
        }
        unsigned* o = top1 + ((size_t)(t0 + tid) * 16 + hp) * 16;
#pragma unroll
        for (int i = 0; i < 4; ++i) *(uint4*)(o + 4 * i) = make_uint4(top[4 * i], top[4 * i + 1], top[4 * i + 2], top[4 * i + 3]);
    }
    __syncthreads();
}

__device__ __forceinline__ void k_cand(int bid, const unsigned* __restrict__ top1, int* __restrict__ sel_id, float* __restrict__ sel_g) {
    const int gid = bid * 256 + threadIdx.x;
    const int t = gid >> 3, h = gid & 7;
    const unsigned* p0 = top1 + ((size_t)t * 16 + h * 2) * 16;
    const unsigned* p1 = p0 + 16;
    float s1[16], s2[16];
#pragma unroll
    for (int i = 0; i < 4; ++i) {
        const uint4 a = *(const uint4*)(p0 + 4 * i), b = *(const uint4*)(p1 + 4 * i);
        s1[4 * i] = keyf(a.x & ~0x7Fu); s1[4 * i + 1] = keyf(a.y & ~0x7Fu); s1[4 * i + 2] = keyf(a.z & ~0x7Fu); s1[4 * i + 3] = keyf(a.w & ~0x7Fu);
        s2[4 * i] = keyf(b.x & ~0x7Fu); s2[4 * i + 1] = keyf(b.y & ~0x7Fu); s2[4 * i + 2] = keyf(b.z & ~0x7Fu); s2[4 * i + 3] = keyf(b.w & ~0x7Fu);
    }
    unsigned top[16];
#pragma unroll
    for (int i = 0; i < 16; ++i) top[i] = 0u;
#pragma unroll
    for (int a = 0; a < 16; ++a)
#pragma unroll
        for (int b = 0; b < 16; ++b)
            if ((a + 1) * (b + 1) <= 16) {
                const unsigned v = (fkey(s1[a] + s2[b]) & ~0xFFu) | (unsigned)(a * 16 + b);
                if (v > top[15]) {
                    top[15] = v;
#pragma unroll
                    for (int i = 15; i > 0; --i) {
                        const unsigned hi = max(top[i - 1], top[i]), lo = min(top[i - 1], top[i]);
                        top[i - 1] = hi; top[i] = lo;
                    }
                }
            }
    float ex[16], sum = 0.f;
    const float m = keyf(top[0] & ~0xFFu);
#pragma unroll
    for (int i = 0; i < 16; ++i) { ex[i] = __expf(keyf(top[i] & ~0xFFu) - m); sum += ex[i]; }
    const float inv = 1.f / sum;
#pragma unroll
    for (int i = 0; i < 16; ++i) {
        const int ab = top[i] & 0xFF;
        const int i1 = p0[ab >> 4] & 0x7F, i2 = p1[ab & 15] & 0x7F;
        sel_id[(size_t)t * 128 + h * 16 + i] = i1 * 128 + i2;
        sel_g[(size_t)t * 128 + h * 16 + i] = ex[i] * inv;
    }
}

__device__ __forceinline__ void k_peer(int bid, const float* x2, const float* __restrict__ r2, const float* __restrict__ ln2_w,
                                              const int* __restrict__ sel_id, const float* __restrict__ sel_g,
                                              const float* __restrict__ peer_u, const float* __restrict__ peer_v, const float* __restrict__ lnf_w,
                                              float* out) {
    const int t = bid * 4 + (threadIdx.x >> 6), lane = threadIdx.x & 63;
    float4 xv[4], h2[4], acc[4];
    const float rr = r2[t];
#pragma unroll
    for (int j = 0; j < 4; ++j) {
        const int c = j * 256 + lane * 4;
        xv[j] = *(const float4*)(x2 + (size_t)t * 1024 + c);
        const float4 w = *(const float4*)(ln2_w + c);
        h2[j] = make_float4(xv[j].x * rr * w.x, xv[j].y * rr * w.y, xv[j].z * rr * w.z, xv[j].w * rr * w.w);
        acc[j] = make_float4(0.f, 0.f, 0.f, 0.f);
    }
    const int id0 = sel_id[(size_t)t * 128 + lane], id1 = sel_id[(size_t)t * 128 + 64 + lane];
    const float gg0 = sel_g[(size_t)t * 128 + lane], gg1 = sel_g[(size_t)t * 128 + 64 + lane];
    for (int half = 0; half < 2; ++half) {
        const int idv = half ? id1 : id0;
        const float gv = half ? gg1 : gg0;
#pragma unroll 4
        for (int k = 0; k < 64; ++k) {
            const int id = __builtin_amdgcn_readlane(idv, k);
            const float gate = __uint_as_float(__builtin_amdgcn_readlane(__float_as_uint(gv), k));
            const float* ur = peer_u + (size_t)id * 1024 + lane * 4;
            float d = 0.f;
#pragma unroll
            for (int j = 0; j < 4; ++j) {
                const float4 u4 = *(const float4*)(ur + 256 * j);
                d += u4.x * h2[j].x + u4.y * h2[j].y + u4.z * h2[j].z + u4.w * h2[j].w;
            }
            d = wave_sum(d);
            const float c = gate * 0.5f * d * (1.f + erff(d * 0.70710678118654752f));
            const float* vr = peer_v + (size_t)id * 1024 + lane * 4;
#pragma unroll
            for (int j = 0; j < 4; ++j) {
                const float4 v4 = *(const float4*)(vr + 256 * j);
                acc[j].x += c * v4.x; acc[j].y += c * v4.y; acc[j].z += c * v4.z; acc[j].w += c * v4.w;
            }
        }
    }
    float ss = 0.f;
#pragma unroll
    for (int j = 0; j < 4; ++j) {
        acc[j].x += xv[j].x; acc[j].y += xv[j].y; acc[j].z += xv[j].z; acc[j].w += xv[j].w;
        ss += acc[j].x * acc[j].x + acc[j].y * acc[j].y + acc[j].z * acc[j].z + acc[j].w * acc[j].w;
    }
    ss = wave_sum(ss);
    const float rs = rsqrtf(ss * (1.f / 1024.f) + EPS);
#pragma unroll
    for (int j = 0; j < 4; ++j) {
        const int c = j * 256 + lane * 4;
        const float4 w = *(const float4*)(lnf_w + c);
        *(float4*)(out + (size_t)t * 1024 + c) = make_float4(acc[j].x * rs * w.x, acc[j].y * rs * w.y, acc[j].z * rs * w.z, acc[j].w * rs * w.w);
    }
}

struct Params {
    const float* in[15];
    float* out;
    unsigned char* ws;
};
constexpr size_t MiB = 1024 * 1024;
constexpr size_t OFF_WIN = 0;
constexpr size_t OFF_WOUT = OFF_WIN + (size_t)NPROJ * 1024 * 2;
constexpr size_t OFF_WQ = OFF_WOUT + (size_t)1024 * 1024 * 2;
constexpr size_t OFF_KEYS = OFF_WQ + (size_t)2048 * 1024 * 2;
constexpr size_t OFF_R1 = OFF_KEYS + (size_t)16 * 128 * 128 * 2;
constexpr size_t OFF_R2 = OFF_R1 + 65536;
constexpr size_t OFF_GDEC = OFF_R2 + 65536;
constexpr size_t OFF_BETA = OFF_GDEC + 262144;
constexpr size_t OFF_C = ((OFF_BETA + 262144 + MiB - 1) / MiB) * MiB;
constexpr size_t OFF_D = OFF_C + 32 * MiB;
constexpr size_t OFF_E = OFF_D + 112 * MiB;
constexpr size_t WS_END = OFF_E + 64 * MiB;
constexpr int SMEM_BYTES = 2 * 2 * 128 * GLD * 2;

#define GRID_LOOP(b, n) for (int b = blockIdx.x; b < (n); b += gridDim.x)

__global__ __launch_bounds__(256) void mega(Params p) {
    cg::grid_group grid = cg::this_grid();
    __shared__ __attribute__((aligned(16))) unsigned char smem[SMEM_BYTES];
    const float* x = p.in[0]; const float* ln1_w = p.in[1]; const float* w_in = p.in[2]; const float* ret_norm_w = p.in[3];
    const float* conv_w = p.in[4]; const float* A_log = p.in[5]; const float* dt_bias = p.in[6]; const float* gdn_norm_w = p.in[7];
    const float* w_out = p.in[8]; const float* ln2_w = p.in[9]; const float* peer_wq = p.in[10]; const float* peer_keys = p.in[11];
    const float* peer_u = p.in[12]; const float* peer_v = p.in[13]; const float* lnf_w = p.in[14];
    float* out = p.out; unsigned char* ws = p.ws;
    bf16_t* WinT = (bf16_t*)(ws + OFF_WIN); bf16_t* WoutT = (bf16_t*)(ws + OFF_WOUT); bf16_t* WqT = (bf16_t*)(ws + OFF_WQ); bf16_t* keysb = (bf16_t*)(ws + OFF_KEYS);
    float* r1 = (float*)(ws + OFF_R1); float* r2 = (float*)(ws + OFF_R2); float* gdec = (float*)(ws + OFF_GDEC); float* beta = (float*)(ws + OFF_BETA);
    bf16_t* xb = (bf16_t*)(ws + OFF_C); bf16_t* x2b = xb;
    bf16_t* projb = (bf16_t*)(ws + OFF_D); bf16_t* qp = projb;
    unsigned* top1 = (unsigned*)(ws + OFF_D + 64 * MiB); int* sel_id = (int*)(ws + OFF_D + 80 * MiB); float* sel_g = (float*)(ws + OFF_D + 88 * MiB);
    bf16_t* cq = (bf16_t*)(ws + OFF_E); bf16_t* mixed = cq; bf16_t* ck = (bf16_t*)(ws + OFF_E + 16 * MiB); bf16_t* cv = (bf16_t*)(ws + OFF_E + 32 * MiB);
    bf16_t* rqr = (bf16_t*)(ws + OFF_E + 48 * MiB); bf16_t* rkr = (bf16_t*)(ws + OFF_E + 56 * MiB);
    float* o_r = out; float* o_g = out + (size_t)T_ * 512;

    GRID_LOOP(b, T_ / 4) k_prep_x(b, x, ln1_w, w_in, A_log, dt_bias, xb, r1, gdec, beta);
    GRID_LOOP(b, (NPROJ / 32) * 32) k_transpose(b % (NPROJ / 32), b / (NPROJ / 32), (float(*)[33])smem, w_in, LDWIN, ln1_w, WinT, 1024);
    GRID_LOOP(b, 32 * 32) k_transpose(b % 32, b / 32, (float(*)[33])smem, w_out, 1024, nullptr, WoutT, 1024);
    GRID_LOOP(b, 64 * 32) k_transpose(b % 64, b / 64, (float(*)[33])smem, peer_wq, 2048, ln2_w, WqT, 1024);
    GRID_LOOP(b, (16 * 128 * 128 / 4) / 256) k_convert(b, peer_keys, keysb, 16 * 128 * 128 / 4);
    grid.sync();
    GRID_LOOP(b, (T_ / 128) * (NPROJ / 128)) k_gemm<0>(b, smem, xb, 1024, WinT, 1024, 1024, projb, NPROJ, r1, NPROJ / 128);
    grid.sync();
    GRID_LOOP(b, T_) k_preproc(b, projb, conv_w, rqr, rkr, cq, ck, cv);
    grid.sync();
    {
        const int gw = blockIdx.x * 4 + (threadIdx.x >> 6);
        for (int w = gw; w < 1024; w += gridDim.x * 4) {
            if (w < 512) k_recur_gdn(w, cq, ck, cv, gdec, beta, o_g);
            else k_recur_ret(w - 512, rqr, rkr, projb, o_r);
        }
    }
    grid.sync();
    GRID_LOOP(b, T_ * 8 / 4) k_mixnorm(b, o_r, o_g, projb, ret_norm_w, gdn_norm_w, mixed);
    grid.sync();
    GRID_LOOP(b, (T_ / 128) * 8) k_gemm<1>(b, smem, mixed, 1024, WoutT, 1024, 1024, out, 1024, x, 8);
    grid.sync();
    GRID_LOOP(b, T_ / 4) k_rownorm2(b, out, x2b, r2);
    grid.sync();
    GRID_LOOP(b, (T_ / 128) * 16) k_gemm<0>(b, smem, x2b, 1024, WqT, 1024, 1024, qp, 2048, r2, 16);
    grid.sync();
    GRID_LOOP(b, (T_ / 128) * 16) k_scores_topk(b, smem, qp, keysb, top1);
    grid.sync();
    GRID_LOOP(b, T_ * 8 / 256) k_cand(b, top1, sel_id, sel_g);
    grid.sync();
    GRID_LOOP(b, T_ / 4) k_peer(b, out, r2, ln2_w, sel_id, sel_g, peer_u, peer_v, lnf_w, out);
}

extern "C" void kernel_launch(void* const* d_in, const int* in_sizes, int n_in, void* d_out, int out_size, void* d_ws, size_t ws_size, hipStream_t stream) {
    static int grid_blocks = 0;
    if (!grid_blocks) {
        int dev = 0, cus = 0, per_cu = 0;
        hipGetDevice(&dev);
        hipDeviceGetAttribute(&cus, hipDeviceAttributeMultiprocessorCount, dev);
        hipOccupancyMaxActiveBlocksPerMultiprocessor(&per_cu, mega, 256, 0);
        if (per_cu > 2) per_cu = 2;
        if (per_cu < 1) per_cu = 1;
        grid_blocks = cus * per_cu;
    }
    if (n_in < 15 || ws_size < WS_END) { fprintf(stderr, "kernel_launch: unexpected inputs / workspace (%d inputs, %zu bytes)\n", n_in, ws_size); return; }
    Params p{};
    for (int i = 0; i < 15; ++i) p.in[i] = (const float*)d_in[i];
    p.out = (float*)d_out; p.ws = (unsigned char*)d_ws;
    void* args[] = {&p};
    hipError_t e = hipLaunchCooperativeKernel((const void*)mega, dim3(grid_blocks), dim3(256), args, 0, stream);
    if (e != hipSuccess) fprintf(stderr, "cooperative launch failed: %s (grid %d)\n", hipGetErrorString(e), grid_blocks);
}
```

```cpp
#include <hip/hip_runtime.h>
#include <hip/hip_cooperative_groups.h>
#include <stdint.h>
#include <cstdio>
namespace cg = cooperative_groups;

typedef unsigned short bf16_t;
typedef __attribute__((ext_vector_type(8))) short bf16x8;
typedef __attribute__((ext_vector_type(4))) float f32x4;

constexpr int T_ = 16384;
constexpr int NPROJ = 3584;
constexpr int LDWIN = 3592;
constexpr float EPS = 1e-6f;

constexpr int C_RQ = 0, C_RK = 256, C_RV = 512, C_RG = 1024, C_GQ = 1536, C_GK = 2048, C_GV = 2560, C_GZ = 3072;

__constant__ double INVREV[32] = {0.15915494309189535, 0.11934937021124886, 0.08949940160889101, 0.06711508300522726, 0.050329212104487035, 0.03774158471741977, 0.0283021958306234, 0.02122365276477766, 0.015915494309189534, 0.011934937021124886, 0.0089499401608891, 0.006711508300522725, 0.005032921210448704, 0.003774158471741977, 0.00283021958306234, 0.002122365276477766, 0.0015915494309189536, 0.0011934937021124887, 0.0008949940160889102, 0.0006711508300522725, 0.0005032921210448703, 0.0003774158471741977, 0.00028302195830623395, 0.00021223652764777658, 0.00015915494309189535, 0.00011934937021124886, 8.9499401608891e-05, 6.711508300522725e-05, 5.0329212104487035e-05, 3.774158471741978e-05, 2.83021958306234e-05, 2.122365276477766e-05};

__device__ __forceinline__ bf16_t f2bf(float f) {
    unsigned u = __float_as_uint(f);
    u += 0x7fffu + ((u >> 16) & 1u);
    return (bf16_t)(u >> 16);
}
__device__ __forceinline__ float bf2f(bf16_t h) { return __uint_as_float(((unsigned)h) << 16); }
__device__ __forceinline__ float wave_sum(float v) {
#pragma unroll
    for (int o = 32; o > 0; o >>= 1) v += __shfl_xor(v, o);
    return v;
}
__device__ __forceinline__ float silu(float x) { return x / (1.f + __expf(-x)); }
__device__ __forceinline__ unsigned fkey(float f) { unsigned u = __float_as_uint(f); return (u & 0x80000000u) ? ~u : (u | 0x80000000u); }
__device__ __forceinline__ float keyf(unsigned k) { return __uint_as_float((k & 0x80000000u) ? (k & 0x7fffffffu) : ~k); }

__device__ __forceinline__ void k_prep_x(int bid, const float* __restrict__ x, const float* __restrict__ ln1_w, const float* __restrict__ w_in,
                                                const float* __restrict__ A_log, const float* __restrict__ dt_bias,
                                                bf16_t* __restrict__ xb, float* __restrict__ r1, float* __restrict__ gdec, float* __restrict__ beta) {
    const int wave = threadIdx.x >> 6, lane = threadIdx.x & 63;
    const int row = bid * 4 + wave;
    const float* xr = x + (size_t)row * 1024;
    float ss = 0.f;
    float g0 = 0, g1 = 0, g2 = 0, g3 = 0, g4 = 0, g5 = 0, g6 = 0, g7 = 0;
#pragma unroll
    for (int j = 0; j < 4; ++j) {
        const int c = j * 256 + lane * 4;
        const float4 v = *(const float4*)(xr + c);
        const float4 w = *(const float4*)(ln1_w + c);
        ss += v.x * v.x + v.y * v.y + v.z * v.z + v.w * v.w;
        ushort4 o; o.x = f2bf(v.x); o.y = f2bf(v.y); o.z = f2bf(v.z); o.w = f2bf(v.w);
        *(ushort4*)(xb + (size_t)row * 1024 + c) = o;
        const float xs[4] = {v.x * w.x, v.y * w.y, v.z * w.z, v.w * w.w};
#pragma unroll
        for (int e = 0; e < 4; ++e) {
            const float* wp = w_in + (size_t)(c + e) * LDWIN + NPROJ;
            const float4 a = *(const float4*)wp; const float4 b = *(const float4*)(wp + 4);
            g0 += xs[e] * a.x; g1 += xs[e] * a.y; g2 += xs[e] * a.z; g3 += xs[e] * a.w;
            g4 += xs[e] * b.x; g5 += xs[e] * b.y; g6 += xs[e] * b.z; g7 += xs[e] * b.w;
        }
    }
    ss = wave_sum(ss);
    g0 = wave_sum(g0); g1 = wave_sum(g1); g2 = wave_sum(g2); g3 = wave_sum(g3);
    g4 = wave_sum(g4); g5 = wave_sum(g5); g6 = wave_sum(g6); g7 = wave_sum(g7);
    const float r = rsqrtf(ss * (1.f / 1024.f) + EPS);
    if (lane == 0) {
        r1[row] = r;
        const float ga[4] = {g0 * r, g1 * r, g2 * r, g3 * r};
        const float gb[4] = {g4 * r, g5 * r, g6 * r, g7 * r};
#pragma unroll
        for (int h = 0; h < 4; ++h) {
            const float xx = ga[h] + dt_bias[h];
            const float sp = xx > 20.f ? xx : log1pf(expf(xx));
            gdec[row * 4 + h] = -expf(A_log[h]) * sp;
            beta[row * 4 + h] = 1.f / (1.f + expf(-gb[h]));
        }
    }
}

__device__ __forceinline__ void k_transpose(int bidx, int bidy, float (*tile)[33], const float* __restrict__ src, int ld, const float* __restrict__ scale, bf16_t* __restrict__ dst, int K) {
    const int n0 = bidx * 32, k0 = bidy * 32;
    const int tx = threadIdx.x & 31, ty = threadIdx.x >> 5;
#pragma unroll
    for (int j = 0; j < 4; ++j) {
        const int k = k0 + ty + 8 * j;
        const float s = scale ? scale[k] : 1.f;
        tile[ty + 8 * j][tx] = src[(size_t)k * ld + n0 + tx] * s;
    }
    __syncthreads();
#pragma unroll
    for (int j = 0; j < 4; ++j) {
        const int n = n0 + ty + 8 * j;
        dst[(size_t)n * K + k0 + tx] = f2bf(tile[tx][ty + 8 * j]);
    }
    __syncthreads();
}

__device__ __forceinline__ void k_convert(int bid, const float* __restrict__ src, bf16_t* __restrict__ dst, int n4) {
    const int i = bid * 256 + threadIdx.x;
    if (i < n4) {
        const float4 v = ((const float4*)src)[i];
        ushort4 o; o.x = f2bf(v.x); o.y = f2bf(v.y); o.z = f2bf(v.z); o.w = f2bf(v.w);
        ((ushort4*)dst)[i] = o;
    }
}

constexpr int GLD = 72;
template <int EPI>
__device__ __forceinline__ void k_gemm(int bid, unsigned char* smem, const bf16_t* __restrict__ A, int lda, const bf16_t* __restrict__ Bt, int ldb, int K,
                                              void* __restrict__ Cv, int ldc, const float* __restrict__ aux, int ntn) {
    bf16_t (*As)[128][GLD] = (bf16_t(*)[128][GLD])smem;
    bf16_t (*Bs)[128][GLD] = (bf16_t(*)[128][GLD])(smem + 2 * 128 * GLD * 2);
    const int tid = threadIdx.x, lane = tid & 63, w = tid >> 6;
    const int wr = w >> 1, wc = w & 1, r = lane & 15, quad = lane >> 4;
    const int tm = bid / ntn, tn = bid % ntn;
    const int m0 = tm * 128, n0 = tn * 128;
    const bf16_t* Ag = A + (size_t)m0 * lda;
    const bf16_t* Bg = Bt + (size_t)n0 * ldb;
    f32x4 acc[4][4];
#pragma unroll
    for (int i = 0; i < 4; ++i)
#pragma unroll
        for (int j = 0; j < 4; ++j) acc[i][j] = (f32x4){0.f, 0.f, 0.f, 0.f};
    uint4 ra[4], rb[4];
    const int nk = K / 64;
#pragma unroll
    for (int j = 0; j < 4; ++j) {
        const int c = tid + 256 * j, row = c >> 3, cc = c & 7;
        ra[j] = *(const uint4*)(Ag + (size_t)row * lda + cc * 8);
        rb[j] = *(const uint4*)(Bg + (size_t)row * ldb + cc * 8);
    }
#pragma unroll
    for (int j = 0; j < 4; ++j) {
        const int c = tid + 256 * j, row = c >> 3, cc = c & 7;
        *(uint4*)&As[0][row][cc * 8] = ra[j];
        *(uint4*)&Bs[0][row][cc * 8] = rb[j];
    }
    __syncthreads();
    for (int kt = 0; kt < nk; ++kt) {
        const int buf = kt & 1;
        const int kn = (kt + 1 < nk) ? kt + 1 : kt;
#pragma unroll
        for (int j = 0; j < 4; ++j) {
            const int c = tid + 256 * j, row = c >> 3, cc = c & 7;
            ra[j] = *(const uint4*)(Ag + (size_t)row * lda + kn * 64 + cc * 8);
            rb[j] = *(const uint4*)(Bg + (size_t)row * ldb + kn * 64 + cc * 8);
        }
        const bf16_t (*Ab)[GLD] = As[buf];
        const bf16_t (*Bb)[GLD] = Bs[buf];
#pragma unroll
        for (int ks = 0; ks < 2; ++ks) {
            bf16x8 a[4], b[4];
#pragma unroll
            for (int i = 0; i < 4; ++i) a[i] = *(const bf16x8*)&Ab[wr * 64 + i * 16 + r][ks * 32 + quad * 8];
#pragma unroll
            for (int j = 0; j < 4; ++j) b[j] = *(const bf16x8*)&Bb[wc * 64 + j * 16 + r][ks * 32 + quad * 8];
#pragma unroll
            for (int i = 0; i < 4; ++i)
#pragma unroll
                for (int j = 0; j < 4; ++j) acc[i][j] = __builtin_amdgcn_mfma_f32_16x16x32_bf16(b[j], a[i], acc[i][j], 0, 0, 0);
        }
        bf16_t (*An)[GLD] = As[buf ^ 1];
        bf16_t (*Bn)[GLD] = Bs[buf ^ 1];
#pragma unroll
        for (int j = 0; j < 4; ++j) {
            const int c = tid + 256 * j, row = c >> 3, cc = c & 7;
            *(uint4*)&An[row][cc * 8] = ra[j];
            *(uint4*)&Bn[row][cc * 8] = rb[j];
        }
        __syncthreads();
    }
#pragma unroll
    for (int i = 0; i < 4; ++i) {
        const int row = m0 + wr * 64 + i * 16 + r;
        float rs = 1.f;
        if (EPI == 0) rs = aux[row];
#pragma unroll
        for (int j = 0; j < 4; ++j) {
            const int col = n0 + wc * 64 + j * 16 + quad * 4;
            if (EPI == 0) {
                ushort4 o; o.x = f2bf(acc[i][j][0] * rs); o.y = f2bf(acc[i][j][1] * rs); o.z = f2bf(acc[i][j][2] * rs); o.w = f2bf(acc[i][j][3] * rs);
                *(ushort4*)((bf16_t*)Cv + (size_t)row * ldc + col) = o;
            } else {
                const float4 xr = *(const float4*)(aux + (size_t)row * ldc + col);
                float4 o; o.x = xr.x + acc[i][j][0]; o.y = xr.y + acc[i][j][1]; o.z = xr.z + acc[i][j][2]; o.w = xr.w + acc[i][j][3];
                *(float4*)((float*)Cv + (size_t)row * ldc + col) = o;
            }
        }
    }
}

__device__ __forceinline__ void k_preproc(int bid, const bf16_t* __restrict__ projb, const float* __restrict__ conv_w,
                                                 bf16_t* __restrict__ rqr, bf16_t* __restrict__ rkr,
                                                 bf16_t* __restrict__ cq, bf16_t* __restrict__ ck, bf16_t* __restrict__ cv) {
    const int t = bid, tid = threadIdx.x;
    {
        const int which = tid >> 7, h = (tid >> 5) & 3, j = tid & 31;
        const bf16_t* p = projb + (size_t)t * NPROJ + which * 256 + h * 64;
        const float a = bf2f(p[j]), b = bf2f(p[j + 32]);
        double u = (double)t * INVREV[j];
        u -= rint(u);
        const float fr = (float)u;
        const float sn = __builtin_amdgcn_sinf(fr), cs = __builtin_amdgcn_cosf(fr);
        const float sc = which ? 0.125f : 1.f;
        bf16_t* o = (which ? rkr : rqr) + (size_t)t * 256 + h * 64;
        o[j] = f2bf((a * cs - b * sn) * sc);
        o[j + 32] = f2bf((a * sn + b * cs) * sc);
    }
    {
        const int h = tid >> 6, l = tid & 63;
        float vals[3][2];
#pragma unroll
        for (int part = 0; part < 3; ++part)
#pragma unroll
            for (int e = 0; e < 2; ++e) {
                const int c = part * 512 + h * 128 + 2 * l + e;
                float acc = 0.f;
#pragma unroll
                for (int j = 0; j < 4; ++j) {
                    const int tt = t - 3 + j;
                    if (tt >= 0) acc += conv_w[j * 1536 + c] * bf2f(projb[(size_t)tt * NPROJ + C_GQ + c]);
                }
                vals[part][e] = silu(acc);
            }
        const float sq = wave_sum(vals[0][0] * vals[0][0] + vals[0][1] * vals[0][1]);
        const float sk = wave_sum(vals[1][0] * vals[1][0] + vals[1][1] * vals[1][1]);
        const float rq = rsqrtf(sq + EPS), rk = rsqrtf(sk + EPS);
        const size_t o = (size_t)t * 512 + h * 128 + 2 * l;
        cq[o] = f2bf(vals[0][0] * rq); cq[o + 1] = f2bf(vals[0][1] * rq);
        ck[o] = f2bf(vals[1][0] * rk); ck[o + 1] = f2bf(vals[1][1] * rk);
        cv[o] = f2bf(vals[2][0]); cv[o + 1] = f2bf(vals[2][1]);
    }
}

__device__ __forceinline__ void k_recur_ret(int bid, const bf16_t* __restrict__ rqr, const bf16_t* __restrict__ rkr, const bf16_t* __restrict__ projb, float* __restrict__ o_r) {
    const int h = bid >> 7, e = bid & 127, lane = threadIdx.x & 63;
    const float gamma = 1.f - exp2f(-5.f - (float)h);
    float s = 0.f;
    const bf16_t* qp = rqr + h * 64 + lane;
    const bf16_t* kp = rkr + h * 64 + lane;
    const bf16_t* vp = projb + C_RV + h * 128 + e;
    for (int t0 = 0; t0 < T_; t0 += 8) {
        float k[8], q[8], v[8];
#pragma unroll
        for (int i = 0; i < 8; ++i) {
            k[i] = bf2f(kp[(size_t)(t0 + i) * 256]);
            q[i] = bf2f(qp[(size_t)(t0 + i) * 256]);
            v[i] = bf2f(vp[(size_t)(t0 + i) * NPROJ]);
        }
#pragma unroll
        for (int i = 0; i < 8; ++i) {
            s = gamma * s + k[i] * v[i];
            const float p = wave_sum(q[i] * s);
            if (lane == 0) o_r[(size_t)(t0 + i) * 512 + h * 128 + e] = p;
        }
    }
}

__device__ __forceinline__ void k_recur_gdn(int bid, const bf16_t* __restrict__ cq, const bf16_t* __restrict__ ck, const bf16_t* __restrict__ cv,
                                                  const float* __restrict__ gdec, const float* __restrict__ beta, float* __restrict__ o_g) {
    const int h = bid >> 7, e = bid & 127, lane = threadIdx.x & 63;
    float s0 = 0.f, s1 = 0.f;
    const bf16_t* qp = cq + h * 128 + 2 * lane;
    const bf16_t* kp = ck + h * 128 + 2 * lane;
    const bf16_t* vp = cv + h * 128 + e;
    for (int t0 = 0; t0 < T_; t0 += 8) {
        float k0[8], k1[8], q0[8], q1[8], v[8], a[8], b[8];
#pragma unroll
        for (int i = 0; i < 8; ++i) {
            const size_t t = t0 + i;
            k0[i] = bf2f(kp[t * 512]); k1[i] = bf2f(kp[t * 512 + 1]);
            q0[i] = bf2f(qp[t * 512]); q1[i] = bf2f(qp[t * 512 + 1]);
            v[i] = bf2f(vp[t * 512]);
            a[i] = __expf(gdec[t * 4 + h]);
            b[i] = beta[t * 4 + h];
        }
#pragma unroll
        for (int i = 0; i < 8; ++i) {
            const float ks = wave_sum(k0[i] * s0 + k1[i] * s1);
            const float coef = b[i] * (v[i] - a[i] * ks);
            s0 = a[i] * s0 + coef * k0[i];
            s1 = a[i] * s1 + coef * k1[i];
            const float o = wave_sum(q0[i] * s0 + q1[i] * s1) * 0.08838834764831845f;
            if (lane == 0) o_g[(size_t)(t0 + i) * 512 + h * 128 + e] = o;
        }
    }
}

__device__ __forceinline__ void k_mixnorm(int bid, const float* __restrict__ o_r, const float* __restrict__ o_g, const bf16_t* __restrict__ projb,
                                                 const float* __restrict__ ret_norm_w, const float* __restrict__ gdn_norm_w, bf16_t* __restrict__ mixed) {
    const int gw = bid * 4 + (threadIdx.x >> 6), l = threadIdx.x & 63;
    const int t = gw >> 3, g = gw & 7;
    if (g < 4) {
        const float2 o = *(const float2*)(o_r + (size_t)t * 512 + g * 128 + 2 * l);
        const float mu = wave_sum(o.x + o.y) * (1.f / 128.f);
        const float d0 = o.x - mu, d1 = o.y - mu;
        const float var = wave_sum(d0 * d0 + d1 * d1) * (1.f / 128.f);
        const float rs = rsqrtf(var + EPS);
        const bf16_t* gp = projb + (size_t)t * NPROJ + C_RG + g * 128 + 2 * l;
        const float y0 = d0 * rs * ret_norm_w[g * 128 + 2 * l] * silu(bf2f(gp[0]));
        const float y1 = d1 * rs * ret_norm_w[g * 128 + 2 * l + 1] * silu(bf2f(gp[1]));
        bf16_t* mp = mixed + (size_t)t * 1024 + g * 128 + 2 * l;
        mp[0] = f2bf(y0); mp[1] = f2bf(y1);
    } else {
        const int h = g - 4;
        const float2 o = *(const float2*)(o_g + (size_t)t * 512 + h * 128 + 2 * l);
        const float ms = wave_sum(o.x * o.x + o.y * o.y) * (1.f / 128.f);
        const float rs = rsqrtf(ms + EPS);
        const bf16_t* gp = projb + (size_t)t * NPROJ + C_GZ + h * 128 + 2 * l;
        const float y0 = o.x * rs * gdn_norm_w[2 * l] * silu(bf2f(gp[0]));
        const float y1 = o.y * rs * gdn_norm_w[2 * l + 1] * silu(bf2f(gp[1]));
        bf16_t* mp = mixed + (size_t)t * 1024 + 512 + h * 128 + 2 * l;
        mp[0] = f2bf(y0); mp[1] = f2bf(y1);
    }
}

__device__ __forceinline__ void k_rownorm2(int bid, const float* __restrict__ x2, bf16_t* __restrict__ x2b, float* __restrict__ r2) {
    const int row = bid * 4 + (threadIdx.x >> 6), lane = threadIdx.x & 63;
    float ss = 0.f;
#pragma unroll
    for (int j = 0; j < 4; ++j) {
        const int c = j * 256 + lane * 4;
        const float4 v = *(const float4*)(x2 + (size_t)row * 1024 + c);
        ss += v.x * v.x + v.y * v.y + v.z * v.z + v.w * v.w;
        ushort4 o; o.x = f2bf(v.x); o.y = f2bf(v.y); o.z = f2bf(v.z); o.w = f2bf(v.w);
        *(ushort4*)(x2b + (size_t)row * 1024 + c) = o;
    }
    ss = wave_sum(ss);
    if (lane == 0) r2[row] = rsqrtf(ss * (1.f / 1024.f) + EPS);
}

constexpr int SLD = 136;
__device__ __forceinline__ void k_scores_topk(int bid, unsigned char* smem, const bf16_t* __restrict__ qp, const bf16_t* __restrict__ keysb, unsigned* __restrict__ top1) {
    bf16_t (*As)[SLD] = (bf16_t(*)[SLD])smem;
    bf16_t (*Bs)[SLD] = (bf16_t(*)[SLD])(smem + 128 * SLD * 2);
    unsigned (*S)[129] = (unsigned(*)[129])smem;
    const int tid = threadIdx.x, lane = tid & 63, w = tid >> 6;
    const int wr = w >> 1, wc = w & 1, r = lane & 15, quad = lane >> 4;
    const int hp = bid & 15, t0 = (bid >> 4) * 128;
#pragma unroll
    for (int j = 0; j < 8; ++j) {
        const int c = tid + 256 * j, row = c >> 4, cc = c & 15;
        *(uint4*)&As[row][cc * 8] = *(const uint4*)(qp + (size_t)(t0 + row) * 2048 + hp * 128 + cc * 8);
        *(uint4*)&Bs[row][cc * 8] = *(const uint4*)(keysb + (size_t)hp * 16384 + row * 128 + cc * 8);
    }
    __syncthreads();
    f32x4 acc[4][4];
#pragma unroll
    for (int i = 0; i < 4; ++i)
#pragma unroll
        for (int j = 0; j < 4; ++j) acc[i][j] = (f32x4){0.f, 0.f, 0.f, 0.f};
#pragma unroll
    for (int ks = 0; ks < 4; ++ks) {
        bf16x8 a[4], b[4];
#pragma unroll
        for (int i = 0; i < 4; ++i) a[i] = *(const bf16x8*)&As[wr * 64 + i * 16 + r][ks * 32 + quad * 8];
#pragma unroll
        for (int j = 0; j < 4; ++j) b[j] = *(const bf16x8*)&Bs[wc * 64 + j * 16 + r][ks * 32 + quad * 8];
#pragma unroll
        for (int i = 0; i < 4; ++i)
#pragma unroll
            for (int j = 0; j < 4; ++j) acc[i][j] = __builtin_amdgcn_mfma_f32_16x16x32_bf16(b[j], a[i], acc[i][j], 0, 0, 0);
    }
    __syncthreads();
#pragma unroll
    for (int i = 0; i < 4; ++i)
#pragma unroll
        for (int j = 0; j < 4; ++j)
#pragma unroll
            for (int v = 0; v < 4; ++v) {
                const int row = wr * 64 + i * 16 + r, col = wc * 64 + j * 16 + quad * 4 + v;
                S[row][col] = (fkey(acc[i][j][v]) & ~0x7Fu) | (unsigned)col;
            }
    __syncthreads();
    if (tid < 128) {
        unsigned top[16];
#pragma unroll
        for (int i = 0; i < 16; ++i) top[i] = 0u;
        for (int c = 0; c < 128; ++c) {
            const unsigned v = S[tid][c];
            if (v > top[15]) {
                top[15] = v;
#pragma unroll
                for (int i = 15; i > 0; --i) {
                    const unsigned hi = max(top[i - 1], top[i]), lo = min(top[i - 1], top[i]);
                    top[i - 1] = hi; top[i] = lo;
                }
            }
        }
        unsigned* o = top1 + ((size_t)(t0 + tid) * 16 + hp) * 16;
#pragma unroll
        for (int i = 0; i < 4; ++i) *(uint4*)(o + 4 * i) = make_uint4(top[4 * i], top[4 * i + 1], top[4 * i + 2], top[4 * i + 3]);
    }
    __syncthreads();
}

__device__ __forceinline__ void k_cand(int bid, const unsigned* __restrict__ top1, int* __restrict__ sel_id, float* __restrict__ sel_g) {
    const int gid = bid * 256 + threadIdx.x;
    const int t = gid >> 3, h = gid & 7;
    const unsigned* p0 = top1 + ((size_t)t * 16 + h * 2) * 16;
    const unsigned* p1 = p0 + 16;
    float s1[16], s2[16];
#pragma unroll
    for (int i = 0; i < 4; ++i) {
        const uint4 a = *(const uint4*)(p0 + 4 * i), b = *(const uint4*)(p1 + 4 * i);
        s1[4 * i] = keyf(a.x & ~0x7Fu); s1[4 * i + 1] = keyf(a.y & ~0x7Fu); s1[4 * i + 2] = keyf(a.z & ~0x7Fu); s1[4 * i + 3] = keyf(a.w & ~0x7Fu);
        s2[4 * i] = keyf(b.x & ~0x7Fu); s2[4 * i + 1] = keyf(b.y & ~0x7Fu); s2[4 * i + 2] = keyf(b.z & ~0x7Fu); s2[4 * i + 3] = keyf(b.w & ~0x7Fu);
    }
    unsigned top[16];
#pragma unroll
    for (int i = 0; i < 16; ++i) top[i] = 0u;
#pragma unroll
    for (int a = 0; a < 16; ++a)
#pragma unroll
        for (int b = 0; b < 16; ++b)
            if ((a + 1) * (b + 1) <= 16) {
                const unsigned v = (fkey(s1[a] + s2[b]) & ~0xFFu) | (unsigned)(a * 16 + b);
                if (v > top[15]) {
                    top[15] = v;
#pragma unroll
                    for (int i = 15; i > 0; --i) {
                        const unsigned hi = max(top[i - 1], top[i]), lo = min(top[i - 1], top[i]);
                        top[i - 1] = hi; top[i] = lo;
                    }
                }
            }
    float ex[16], sum = 0.f;
    const float m = keyf(top[0] & ~0xFFu);
#pragma unroll
    for (int i = 0; i < 16; ++i) { ex[i] = __expf(keyf(top[i] & ~0xFFu) - m); sum += ex[i]; }
    const float inv = 1.f / sum;
#pragma unroll
    for (int i = 0; i < 16; ++i) {
        const int ab = top[i] & 0xFF;
        const int i1 = p0[ab >> 4] & 0x7F, i2 = p1[ab & 15] & 0x7F;
        sel_id[(size_t)t * 128 + h * 16 + i] = i1 * 128 + i2;
        sel_g[(size_t)t * 128 + h * 16 + i] = ex[i] * inv;
    }
}

__device__ __forceinline__ void k_peer(int bid, const float* x2, const float* __restrict__ r2, const float* __restrict__ ln2_w,
                                              const int* __restrict__ sel_id, const float* __restrict__ sel_g,
                                              const float* __restrict__ peer_u, const float* __restrict__ peer_v, const float* __restrict__ lnf_w,
                                              float* out) {
    const int t = bid * 4 + (threadIdx.x >> 6), lane = threadIdx.x & 63;
    float4 xv[4], h2[4], acc[4];
    const float rr = r2[t];
#pragma unroll
    for (int j = 0; j < 4; ++j) {
        const int c = j * 256 + lane * 4;
        xv[j] = *(const float4*)(x2 + (size_t)t * 1024 + c);
        const float4 w = *(const float4*)(ln2_w + c);
        h2[j] = make_float4(xv[j].x * rr * w.x, xv[j].y * rr * w.y, xv[j].z * rr * w.z, xv[j].w * rr * w.w);
        acc[j] = make_float4(0.f, 0.f, 0.f, 0.f);
    }
    const int id0 = sel_id[(size_t)t * 128 + lane], id1 = sel_id[(size_t)t * 128 + 64 + lane];
    const float gg0 = sel_g[(size_t)t * 128 + lane], gg1 = sel_g[(size_t)t * 128 + 64 + lane];
    for (int half = 0; half < 2; ++half) {
        const int idv = half ? id1 : id0;
        const float gv = half ? gg1 : gg0;
#pragma unroll 4
        for (int k = 0; k < 64; ++k) {
            const int id = __builtin_amdgcn_readlane(idv, k);
            const float gate = __uint_as_float(__builtin_amdgcn_readlane(__float_as_uint(gv), k));
            const float* ur = peer_u + (size_t)id * 1024 + lane * 4;
            float d = 0.f;
#pragma unroll
            for (int j = 0; j < 4; ++j) {
                const float4 u4 = *(const float4*)(ur + 256 * j);
                d += u4.x * h2[j].x + u4.y * h2[j].y + u4.z * h2[j].z + u4.w * h2[j].w;
            }
            d = wave_sum(d);
            const float c = gate * 0.5f * d * (1.f + erff(d * 0.70710678118654752f));
            const float* vr = peer_v + (size_t)id * 1024 + lane * 4;
#pragma unroll
            for (int j = 0; j < 4; ++j) {
                const float4 v4 = *(const float4*)(vr + 256 * j);
                acc[j].x += c * v4.x; acc[j].y += c * v4.y; acc[j].z += c * v4.z; acc[j].w += c * v4.w;
            }
        }
    }
    float ss = 0.f;
#pragma unroll
    for (int j = 0; j < 4; ++j) {
        acc[j].x += xv[j].x; acc[j].y += xv[j].y; acc[j].z += xv[j].z; acc[j].w += xv[j].w;
        ss += acc[j].x * acc[j].x + acc[j].y * acc[j].y + acc[j].z * acc[j].z + acc[j].w * acc[j].w;
    }
    ss = wave_sum(ss);
    const float rs = rsqrtf(ss * (1.f / 1024.f) + EPS);
#pragma unroll
    for (int j = 0; j < 4; ++j) {
        const int c = j * 256 + lane * 4;
        const float4 w = *(const float4*)(lnf_w + c);
        *(float4*)(out + (size_t)t * 1024 + c) = make_float4(acc[j].x * rs * w.x, acc[j].y * rs * w.y, acc[j].z * rs * w.z, acc[j].w * rs * w.w);
    }
}

constexpr int LDT = 136;
constexpr float QSCALE = 0.08838834764831845f;
constexpr size_t CH = 128 * 128;

__device__ __forceinline__ f32x4 mfma16(bf16x8 a, bf16x8 b, f32x4 c) { return __builtin_amdgcn_mfma_f32_16x16x32_bf16(a, b, c, 0, 0, 0); }
__device__ __forceinline__ uint2 pack4(float a, float b, float c, float d) {
    uint2 r; r.x = (unsigned)f2bf(a) | ((unsigned)f2bf(b) << 16); r.y = (unsigned)f2bf(c) | ((unsigned)f2bf(d) << 16); return r;
}
__device__ __forceinline__ int lrow(int i) {
    const int m = i - 1, a = m >> 2, b = m & 3;
    return i <= 0 ? 0 : 8 * a * (a + 1) + 4 * b * (a + 1);
}
constexpr int LROW_TOTAL = 8320;

__device__ __forceinline__ void conv_norm_rows(const bf16_t* __restrict__ projb, int t0, int colbase, const float* cw, bf16_t (*tile)[LDT], bf16_t* gout) {
    const int tid = threadIdx.x, i = tid >> 1, hf = tid & 1;
    float vals[64];
    float ss = 0.f;
#pragma unroll
    for (int g = 0; g < 8; ++g) {
        float acc[8];
#pragma unroll
        for (int k = 0; k < 8; ++k) acc[k] = 0.f;
#pragma unroll
        for (int j = 0; j < 4; ++j) {
            const int tt = t0 + i - 3 + j;
            if (tt >= 0) {
                const uint4 raw = *(const uint4*)(projb + (size_t)tt * NPROJ + colbase + hf * 64 + g * 8);
                const float4 w0 = *(const float4*)(cw + j * 128 + hf * 64 + g * 8), w1 = *(const float4*)(cw + j * 128 + hf * 64 + g * 8 + 4);
                acc[0] += w0.x * __uint_as_float(raw.x << 16); acc[1] += w0.y * __uint_as_float(raw.x & 0xffff0000u);
                acc[2] += w0.z * __uint_as_float(raw.y << 16); acc[3] += w0.w * __uint_as_float(raw.y & 0xffff0000u);
                acc[4] += w1.x * __uint_as_float(raw.z << 16); acc[5] += w1.y * __uint_as_float(raw.z & 0xffff0000u);
                acc[6] += w1.z * __uint_as_float(raw.w << 16); acc[7] += w1.w * __uint_as_float(raw.w & 0xffff0000u);
            }
        }
#pragma unroll
        for (int k = 0; k < 8; ++k) { const float s = silu(acc[k]); vals[g * 8 + k] = s; ss += s * s; }
    }
    ss += __shfl_xor(ss, 1);
    const float rs = rsqrtf(ss + EPS);
#pragma unroll
    for (int g = 0; g < 8; ++g) {
        const uint2 p0 = pack4(vals[g * 8] * rs, vals[g * 8 + 1] * rs, vals[g * 8 + 2] * rs, vals[g * 8 + 3] * rs);
        const uint2 p1 = pack4(vals[g * 8 + 4] * rs, vals[g * 8 + 5] * rs, vals[g * 8 + 6] * rs, vals[g * 8 + 7] * rs);
        const uint4 o = make_uint4(p0.x, p0.y, p1.x, p1.y);
        *(uint4*)&tile[i][hf * 64 + g * 8] = o;
        if (gout) *(uint4*)(gout + (size_t)(t0 + i) * 512 + hf * 64 + g * 8) = o;
    }
}

__device__ __forceinline__ void gdn_phaseA(int item, unsigned char* smem, const bf16_t* __restrict__ projb, const float* __restrict__ conv_w,
                                           const float* __restrict__ gdec, const float* __restrict__ beta,
                                           bf16_t* __restrict__ UT, bf16_t* __restrict__ Wm, bf16_t* __restrict__ KstT, bf16_t* __restrict__ kn, float* __restrict__ gcb) {
    const int h = item & 3, n = item >> 2, t0 = n * 128;
    const int tid = threadIdx.x, lane = tid & 63, w = tid >> 6;
    { int zoff = 0; asm volatile("" : "+s"(zoff)); smem += zoff; }
    float* gs = (float*)smem;
    float* gcs = gs + 128;
    float* bts = gcs + 128;
    float* cw = bts + 128;
    float* Lp = cw + 512;
    bf16_t (*Kt)[LDT] = (bf16_t(*)[LDT])(smem + 3584 + LROW_TOTAL * 4);
    if (tid < 128) { gs[tid] = gdec[(size_t)(t0 + tid) * 4 + h]; bts[tid] = beta[(size_t)(t0 + tid) * 4 + h]; }
    for (int u = tid; u < 512; u += 256) cw[u] = conv_w[(u >> 7) * 1536 + 512 + h * 128 + (u & 127)];
    __syncthreads();
    if (tid < 128) {
        float s = 0.f;
        for (int j = 0; j <= tid; ++j) s += gs[j];
        gcs[tid] = s;
        gcb[(size_t)(h * 128 + n) * 128 + tid] = s;
    }
    conv_norm_rows(projb, t0, C_GK + h * 128, cw, Kt, kn + h * 128);
    __syncthreads();
    {
        const int wr = w >> 1, wc = w & 1, r = lane & 15, quad = lane >> 4;
        if (!(wr == 0 && wc == 1)) {
            f32x4 acc[4][4];
#pragma unroll
            for (int i = 0; i < 4; ++i)
#pragma unroll
                for (int j = 0; j < 4; ++j) acc[i][j] = (f32x4){0.f, 0.f, 0.f, 0.f};
#pragma unroll
            for (int ks = 0; ks < 4; ++ks) {
                bf16x8 a[4], b[4];
#pragma unroll
                for (int i = 0; i < 4; ++i) a[i] = *(const bf16x8*)&Kt[wr * 64 + i * 16 + r][ks * 32 + quad * 8];
#pragma unroll
                for (int j = 0; j < 4; ++j) b[j] = *(const bf16x8*)&Kt[wc * 64 + j * 16 + r][ks * 32 + quad * 8];
#pragma unroll
                for (int i = 0; i < 4; ++i)
#pragma unroll
                    for (int j = 0; j < 4; ++j) acc[i][j] = mfma16(b[j], a[i], acc[i][j]);
            }
#pragma unroll
            for (int i = 0; i < 4; ++i) {
                const int row = wr * 64 + i * 16 + r;
                const float bi = bts[row], gi = gcs[row];
                const int rs = lrow(row);
#pragma unroll
                for (int j = 0; j < 4; ++j) {
                    const int c0 = wc * 64 + j * 16 + quad * 4;
                    if (c0 < row) {
                        float4 o;
                        o.x = (c0 + 0 < row) ? bi * acc[i][j][0] * __expf(gi - gcs[c0 + 0]) : 0.f;
                        o.y = (c0 + 1 < row) ? bi * acc[i][j][1] * __expf(gi - gcs[c0 + 1]) : 0.f;
                        o.z = (c0 + 2 < row) ? bi * acc[i][j][2] * __expf(gi - gcs[c0 + 2]) : 0.f;
                        o.w = (c0 + 3 < row) ? bi * acc[i][j][3] * __expf(gi - gcs[c0 + 3]) : 0.f;
                        *(float4*)&Lp[rs + c0] = o;
                    }
                }
            }
        }
    }
    __syncthreads();
    float x[128];
    const size_t cbase = (size_t)(h * 128 + n) * CH;
    if (tid < 128) {
        const int e = tid;
        const bf16_t* vp = projb + C_GV + h * 128 + e;
        const float w0 = conv_w[0 * 1536 + 1024 + h * 128 + e], w1 = conv_w[1 * 1536 + 1024 + h * 128 + e];
        const float w2 = conv_w[2 * 1536 + 1024 + h * 128 + e], w3 = conv_w[3 * 1536 + 1024 + h * 128 + e];
        float r0 = (t0 >= 3) ? bf2f(vp[(size_t)(t0 - 3) * NPROJ]) : 0.f;
        float r1 = (t0 >= 2) ? bf2f(vp[(size_t)(t0 - 2) * NPROJ]) : 0.f;
        float r2 = (t0 >= 1) ? bf2f(vp[(size_t)(t0 - 1) * NPROJ]) : 0.f;
#pragma unroll
        for (int i = 0; i < 128; ++i) {
            const float r3 = bf2f(vp[(size_t)(t0 + i) * NPROJ]);
            x[i] = bts[i] * silu(w0 * r0 + w1 * r1 + w2 * r2 + w3 * r3);
            r0 = r1; r1 = r2; r2 = r3;
        }
    } else {
        const int d = tid - 128;
#pragma unroll
        for (int i = 0; i < 128; ++i) x[i] = bts[i] * __expf(gcs[i]) * bf2f(Kt[i][d]);
    }
    int zo = 0;
#pragma unroll
    for (int i = 1; i < 128; ++i) {
        float s = x[i];
        asm volatile("" : "+v"(zo) : "v"(x[i - 1]));
        const float* Lr = Lp + zo;
#pragma unroll
        for (int g = 0; g < (i + 3) / 4; ++g) {
            const float4 l = *(const float4*)&Lr[lrow(i) + 4 * g];
            if (4 * g + 0 < i) s -= l.x * x[4 * g + 0];
            if (4 * g + 1 < i) s -= l.y * x[4 * g + 1];
            if (4 * g + 2 < i) s -= l.z * x[4 * g + 2];
            if (4 * g + 3 < i) s -= l.w * x[4 * g + 3];
        }
        x[i] = s;
    }
    if (tid < 128) {
        bf16_t* up = UT + cbase + (size_t)tid * 128;
#pragma unroll
        for (int g = 0; g < 16; ++g) {
            const uint2 p0 = pack4(x[8 * g], x[8 * g + 1], x[8 * g + 2], x[8 * g + 3]), p1 = pack4(x[8 * g + 4], x[8 * g + 5], x[8 * g + 6], x[8 * g + 7]);
            *(uint4*)(up + 8 * g) = make_uint4(p0.x, p0.y, p1.x, p1.y);
        }
    } else {
        const int d = tid - 128;
        const float gl = gcs[127];
        bf16_t* kp = KstT + cbase + (size_t)d * 128;
#pragma unroll
        for (int g = 0; g < 16; ++g) {
            float kv[8];
#pragma unroll
            for (int k = 0; k < 8; ++k) kv[k] = bf2f(Kt[8 * g + k][d]) * __expf(gl - gcs[8 * g + k]);
            const uint2 p0 = pack4(kv[0], kv[1], kv[2], kv[3]), p1 = pack4(kv[4], kv[5], kv[6], kv[7]);
            *(uint4*)(kp + 8 * g) = make_uint4(p0.x, p0.y, p1.x, p1.y);
        }
    }
    __syncthreads();
    if (tid >= 128) {
        const int d = tid - 128;
#pragma unroll
        for (int i = 0; i < 128; ++i) Kt[i][d] = f2bf(x[i]);
    }
    __syncthreads();
#pragma unroll
    for (int j = 0; j < 8; ++j) {
        const int c = tid + 256 * j, row = c >> 4, cc = c & 15;
        *(uint4*)(Wm + cbase + (size_t)row * 128 + cc * 8) = *(const uint4*)&Kt[row][cc * 8];
    }
    __syncthreads();
}

struct ScanFrags { bf16x8 aw[2][4]; bf16x8 ak[2][4]; uint2 u[2][2]; float dec; };
__device__ __forceinline__ void scan_load(ScanFrags& f, int h, int n, int c, int w, int r, int quad,
                                          const bf16_t* __restrict__ UT, const bf16_t* __restrict__ Wm, const bf16_t* __restrict__ KstT, const float* __restrict__ gcb) {
    const size_t cbase = (size_t)(h * 128 + n) * CH;
#pragma unroll
    for (int mt = 0; mt < 2; ++mt)
#pragma unroll
        for (int ks = 0; ks < 4; ++ks) {
            const size_t o = cbase + (size_t)(32 * w + 16 * mt + r) * 128 + ks * 32 + quad * 8;
            f.aw[mt][ks] = *(const bf16x8*)(Wm + o);
            f.ak[mt][ks] = *(const bf16x8*)(KstT + o);
        }
#pragma unroll
    for (int mt = 0; mt < 2; ++mt)
#pragma unroll
        for (int nt = 0; nt < 2; ++nt)
            f.u[mt][nt] = *(const uint2*)(UT + cbase + (size_t)(32 * c + 16 * nt + r) * 128 + 32 * w + 16 * mt + quad * 4);
    f.dec = __expf(gcb[(size_t)(h * 128 + n) * 128 + 127]);
}
__device__ __forceinline__ void scan_step(const ScanFrags& f, f32x4 (&s)[2][2], int h, int n, int c, int w, int r, int quad,
                                          bf16_t (*ST)[LDT], bf16_t (*VT)[LDT], bf16_t* __restrict__ VnT, bf16_t* __restrict__ Sst) {
    f32x4 xa[2][2];
#pragma unroll
    for (int mt = 0; mt < 2; ++mt)
#pragma unroll
        for (int nt = 0; nt < 2; ++nt) xa[mt][nt] = (f32x4){0.f, 0.f, 0.f, 0.f};
#pragma unroll
    for (int ks = 0; ks < 4; ++ks) {
        const bf16x8 b0 = *(const bf16x8*)&ST[r][ks * 32 + quad * 8], b1 = *(const bf16x8*)&ST[16 + r][ks * 32 + quad * 8];
#pragma unroll
        for (int mt = 0; mt < 2; ++mt) { xa[mt][0] = mfma16(f.aw[mt][ks], b0, xa[mt][0]); xa[mt][1] = mfma16(f.aw[mt][ks], b1, xa[mt][1]); }
    }
    const size_t cbase = (size_t)(h * 128 + n) * CH;
#pragma unroll
    for (int mt = 0; mt < 2; ++mt)
#pragma unroll
        for (int nt = 0; nt < 2; ++nt) {
            const uint2 uu = f.u[mt][nt];
            const uint2 p = pack4(__uint_as_float(uu.x << 16) - xa[mt][nt][0], __uint_as_float(uu.x & 0xffff0000u) - xa[mt][nt][1],
                                  __uint_as_float(uu.y << 16) - xa[mt][nt][2], __uint_as_float(uu.y & 0xffff0000u) - xa[mt][nt][3]);
            *(uint2*)&VT[16 * nt + r][32 * w + 16 * mt + quad * 4] = p;
            *(uint2*)(VnT + cbase + (size_t)(32 * c + 16 * nt + r) * 128 + 32 * w + 16 * mt + quad * 4) = p;
        }
    __syncthreads();
#pragma unroll
    for (int mt = 0; mt < 2; ++mt)
#pragma unroll
        for (int nt = 0; nt < 2; ++nt) s[mt][nt] *= f.dec;
#pragma unroll
    for (int ks = 0; ks < 4; ++ks) {
        const bf16x8 b0 = *(const bf16x8*)&VT[r][ks * 32 + quad * 8], b1 = *(const bf16x8*)&VT[16 + r][ks * 32 + quad * 8];
#pragma unroll
        for (int mt = 0; mt < 2; ++mt) { s[mt][0] = mfma16(f.ak[mt][ks], b0, s[mt][0]); s[mt][1] = mfma16(f.ak[mt][ks], b1, s[mt][1]); }
    }
#pragma unroll
    for (int mt = 0; mt < 2; ++mt)
#pragma unroll
        for (int nt = 0; nt < 2; ++nt) {
            const uint2 p = pack4(s[mt][nt][0], s[mt][nt][1], s[mt][nt][2], s[mt][nt][3]);
            *(uint2*)&ST[16 * nt + r][32 * w + 16 * mt + quad * 4] = p;
            if (n + 1 < 128) *(uint2*)(Sst + cbase + CH + (size_t)(32 * c + 16 * nt + r) * 128 + 32 * w + 16 * mt + quad * 4) = p;
        }
    __syncthreads();
}
__device__ __forceinline__ void gdn_scan(int b, unsigned char* smem, const bf16_t* __restrict__ UT, const bf16_t* __restrict__ Wm, const bf16_t* __restrict__ KstT,
                                         const float* __restrict__ gcb, bf16_t* __restrict__ VnT, bf16_t* __restrict__ Sst) {
    const int h = b >> 2, c = b & 3;
    const int tid = threadIdx.x, lane = tid & 63, w = tid >> 6, r = lane & 15, quad = lane >> 4;
    bf16_t (*ST)[LDT] = (bf16_t(*)[LDT])smem;
    bf16_t (*VT)[LDT] = (bf16_t(*)[LDT])(smem + 32 * LDT * 2);
    for (int u = tid; u < 32 * LDT / 2; u += 256) ((unsigned*)smem)[u] = 0u;
    {
        const size_t cb0 = (size_t)(h * 128) * CH;
        for (int u = tid; u < 32 * 16; u += 256) *(uint4*)(Sst + cb0 + (size_t)(32 * c + (u >> 4)) * 128 + (u & 15) * 8) = make_uint4(0u, 0u, 0u, 0u);
    }
    f32x4 s[2][2];
#pragma unroll
    for (int mt = 0; mt < 2; ++mt)
#pragma unroll
        for (int nt = 0; nt < 2; ++nt) s[mt][nt] = (f32x4){0.f, 0.f, 0.f, 0.f};
    __syncthreads();
    ScanFrags f0, f1;
    scan_load(f0, h, 0, c, w, r, quad, UT, Wm, KstT, gcb);
    for (int n = 0; n < 128; n += 2) {
        scan_load(f1, h, n + 1, c, w, r, quad, UT, Wm, KstT, gcb);
        scan_step(f0, s, h, n, c, w, r, quad, ST, VT, VnT, Sst);
        scan_load(f0, h, (n + 2 < 128) ? n + 2 : 127, c, w, r, quad, UT, Wm, KstT, gcb);
        scan_step(f1, s, h, n + 1, c, w, r, quad, ST, VT, VnT, Sst);
    }
}

__device__ __forceinline__ void gdn_phaseC(int item, unsigned char* smem, const bf16_t* __restrict__ projb, const float* __restrict__ conv_w, const bf16_t* __restrict__ kn,
                                           const float* __restrict__ gcb, const bf16_t* __restrict__ VnT, const bf16_t* __restrict__ Sst,
                                           const float* __restrict__ gdn_norm_w, bf16_t* __restrict__ mixed) {
    const int h = item & 3, n = item >> 2, t0 = n * 128;
    const int tid = threadIdx.x, lane = tid & 63, w = tid >> 6;
    const int wr = w >> 1, wc = w & 1, r = lane & 15, quad = lane >> 4;
    { int zoff = 0; asm volatile("" : "+s"(zoff)); smem += zoff; }
    float* gcs = (float*)smem;
    float* cw = gcs + 128;
    float* red = cw + 512;
    bf16_t (*Qt)[LDT] = (bf16_t(*)[LDT])(smem + 3584);
    bf16_t (*Kt)[LDT] = (bf16_t(*)[LDT])(smem + 3584 + 128 * LDT * 2);
    const size_t cbase = (size_t)(h * 128 + n) * CH;
    if (tid < 128) gcs[tid] = gcb[(size_t)(h * 128 + n) * 128 + tid];
    for (int u = tid; u < 512; u += 256) cw[u] = conv_w[(u >> 7) * 1536 + h * 128 + (u & 127)];
#pragma unroll
    for (int j = 0; j < 8; ++j) {
        const int c = tid + 256 * j, row = c >> 4, cc = c & 15;
        *(uint4*)&Kt[row][cc * 8] = *(const uint4*)(kn + (size_t)(t0 + row) * 512 + h * 128 + cc * 8);
    }
    __syncthreads();
    conv_norm_rows(projb, t0, C_GQ + h * 128, cw, Qt, nullptr);
    __syncthreads();
    f32x4 acc[4][4];
#pragma unroll
    for (int i = 0; i < 4; ++i)
#pragma unroll
        for (int j = 0; j < 4; ++j) acc[i][j] = (f32x4){0.f, 0.f, 0.f, 0.f};
    if (!(wr == 0 && wc == 1)) {
#pragma unroll
        for (int ks = 0; ks < 4; ++ks) {
            bf16x8 a[4], b[4];
#pragma unroll
            for (int i = 0; i < 4; ++i) a[i] = *(const bf16x8*)&Qt[wr * 64 + i * 16 + r][ks * 32 + quad * 8];
#pragma unroll
            for (int j = 0; j < 4; ++j) b[j] = *(const bf16x8*)&Kt[wc * 64 + j * 16 + r][ks * 32 + quad * 8];
#pragma unroll
            for (int i = 0; i < 4; ++i)
#pragma unroll
                for (int j = 0; j < 4; ++j) acc[i][j] = mfma16(b[j], a[i], acc[i][j]);
        }
    }
    __syncthreads();
#pragma unroll
    for (int i = 0; i < 4; ++i) {
        const int row = wr * 64 + i * 16 + r;
        const float gi = gcs[row];
#pragma unroll
        for (int j = 0; j < 4; ++j) {
            const int c0 = wc * 64 + j * 16 + quad * 4;
            float o[4];
#pragma unroll
            for (int v = 0; v < 4; ++v) o[v] = (c0 + v <= row) ? acc[i][j][v] * QSCALE * __expf(gi - gcs[c0 + v]) : 0.f;
            *(uint2*)&Kt[row][c0] = pack4(o[0], o[1], o[2], o[3]);
        }
    }
    __syncthreads();
#pragma unroll
    for (int i = 0; i < 4; ++i)
#pragma unroll
        for (int j = 0; j < 4; ++j) acc[i][j] = (f32x4){0.f, 0.f, 0.f, 0.f};
#pragma unroll
    for (int ks = 0; ks < 4; ++ks) {
        bf16x8 a[4], b[4];
#pragma unroll
        for (int i = 0; i < 4; ++i) a[i] = *(const bf16x8*)&Qt[wr * 64 + i * 16 + r][ks * 32 + quad * 8];
#pragma unroll
        for (int j = 0; j < 4; ++j) b[j] = *(const bf16x8*)(Sst + cbase + (size_t)(wc * 64 + j * 16 + r) * 128 + ks * 32 + quad * 8);
#pragma unroll
        for (int i = 0; i < 4; ++i)
#pragma unroll
            for (int j = 0; j < 4; ++j) acc[i][j] = mfma16(b[j], a[i], acc[i][j]);
    }
#pragma unroll
    for (int i = 0; i < 4; ++i) {
        const float sc = QSCALE * __expf(gcs[wr * 64 + i * 16 + r]);
#pragma unroll
        for (int j = 0; j < 4; ++j) acc[i][j] *= sc;
    }
#pragma unroll
    for (int ks = 0; ks < 4; ++ks) {
        bf16x8 a[4], b[4];
#pragma unroll
        for (int i = 0; i < 4; ++i) a[i] = *(const bf16x8*)&Kt[wr * 64 + i * 16 + r][ks * 32 + quad * 8];
#pragma unroll
        for (int j = 0; j < 4; ++j) b[j] = *(const bf16x8*)(VnT + cbase + (size_t)(wc * 64 + j * 16 + r) * 128 + ks * 32 + quad * 8);
#pragma unroll
        for (int i = 0; i < 4; ++i)
#pragma unroll
            for (int j = 0; j < 4; ++j) acc[i][j] = mfma16(b[j], a[i], acc[i][j]);
    }
#pragma unroll
    for (int i = 0; i < 4; ++i) {
        float ss = 0.f;
#pragma unroll
        for (int j = 0; j < 4; ++j)
#pragma unroll
            for (int v = 0; v < 4; ++v) ss += acc[i][j][v] * acc[i][j][v];
        ss += __shfl_xor(ss, 16); ss += __shfl_xor(ss, 32);
        if (quad == 0) red[wc * 128 + wr * 64 + i * 16 + r] = ss;
    }
    __syncthreads();
#pragma unroll
    for (int i = 0; i < 4; ++i) {
        const int row = wr * 64 + i * 16 + r;
        const float rs = rsqrtf((red[row] + red[128 + row]) * (1.f / 128.f) + EPS);
#pragma unroll
        for (int j = 0; j < 4; ++j) {
            const int e0 = wc * 64 + j * 16 + quad * 4;
            const uint2 gz = *(const uint2*)(projb + (size_t)(t0 + row) * NPROJ + C_GZ + h * 128 + e0);
            const float4 nw = *(const float4*)(gdn_norm_w + e0);
            const uint2 p = pack4(acc[i][j][0] * rs * nw.x * silu(__uint_as_float(gz.x << 16)), acc[i][j][1] * rs * nw.y * silu(__uint_as_float(gz.x & 0xffff0000u)),
                                  acc[i][j][2] * rs * nw.z * silu(__uint_as_float(gz.y << 16)), acc[i][j][3] * rs * nw.w * silu(__uint_as_float(gz.y & 0xffff0000u)));
            *(uint2*)(mixed + (size_t)(t0 + row) * 1024 + 512 + h * 128 + e0) = p;
        }
    }
    __syncthreads();
}


__device__ __forceinline__ void k_rope(int bid, const bf16_t* __restrict__ projb, bf16_t* __restrict__ rqr, bf16_t* __restrict__ rkr) {
    const int t = bid, tid = threadIdx.x;
    const int which = tid >> 7, h = (tid >> 5) & 3, j = tid & 31;
    const bf16_t* p = projb + (size_t)t * NPROJ + which * 256 + h * 64;
    const float a = bf2f(p[j]), b = bf2f(p[j + 32]);
    double u = (double)t * INVREV[j];
    u -= rint(u);
    const float fr = (float)u;
    const float sn = __builtin_amdgcn_sinf(fr), cs = __builtin_amdgcn_cosf(fr);
    const float sc = which ? 0.125f : 1.f;
    bf16_t* o = (which ? rkr : rqr) + (size_t)t * 256 + h * 64;
    o[j] = f2bf((a * cs - b * sn) * sc);
    o[j + 32] = f2bf((a * sn + b * cs) * sc);
}
__device__ __forceinline__ void k_mixnorm_ret(int bid, const float* __restrict__ o_r, const bf16_t* __restrict__ projb, const float* __restrict__ ret_norm_w, bf16_t* __restrict__ mixed) {
    const int gw = bid * 4 + (threadIdx.x >> 6), l = threadIdx.x & 63;
    const int t = gw >> 2, g = gw & 3;
    const float2 o = *(const float2*)(o_r + (size_t)t * 512 + g * 128 + 2 * l);
    const float mu = wave_sum(o.x + o.y) * (1.f / 128.f);
    const float d0 = o.x - mu, d1 = o.y - mu;
    const float var = wave_sum(d0 * d0 + d1 * d1) * (1.f / 128.f);
    const float rs = rsqrtf(var + EPS);
    const bf16_t* gp = projb + (size_t)t * NPROJ + C_RG + g * 128 + 2 * l;
    const float y0 = d0 * rs * ret_norm_w[g * 128 + 2 * l] * silu(bf2f(gp[0]));
    const float y1 = d1 * rs * ret_norm_w[g * 128 + 2 * l + 1] * silu(bf2f(gp[1]));
    bf16_t* mp = mixed + (size_t)t * 1024 + g * 128 + 2 * l;
    mp[0] = f2bf(y0); mp[1] = f2bf(y1);
}

struct Params {
    const float* in[15];
    float* out;
    unsigned char* ws;
};
constexpr size_t MiB = 1024 * 1024;
constexpr size_t OFF_WIN = 0;
constexpr size_t OFF_WOUT = OFF_WIN + (size_t)NPROJ * 1024 * 2;
constexpr size_t OFF_WQ = OFF_WOUT + (size_t)1024 * 1024 * 2;
constexpr size_t OFF_KEYS = OFF_WQ + (size_t)2048 * 1024 * 2;
constexpr size_t OFF_R1 = OFF_KEYS + (size_t)16 * 128 * 128 * 2;
constexpr size_t OFF_R2 = OFF_R1 + 65536;
constexpr size_t OFF_GDEC = OFF_R2 + 65536;
constexpr size_t OFF_BETA = OFF_GDEC + 262144;
constexpr size_t OFF_GCB = OFF_BETA + 262144;
constexpr size_t OFF_C = ((OFF_GCB + 262144 + MiB - 1) / MiB) * MiB;
constexpr size_t OFF_D = OFF_C + 32 * MiB;
constexpr size_t OFF_E = OFF_D + 112 * MiB;
constexpr size_t WS_END = OFF_E + 64 * MiB;
constexpr int SMEM_BYTES = 2 * 2 * 128 * GLD * 2;

#define GRID_LOOP(b, n) for (int b = blockIdx.x; b < (n); b += gridDim.x)

__global__ __launch_bounds__(256) void mega(Params p) {
    cg::grid_group grid = cg::this_grid();
    __shared__ __attribute__((aligned(16))) unsigned char smem[SMEM_BYTES];
    const float* x = p.in[0]; const float* ln1_w = p.in[1]; const float* w_in = p.in[2]; const float* ret_norm_w = p.in[3];
    const float* conv_w = p.in[4]; const float* A_log = p.in[5]; const float* dt_bias = p.in[6]; const float* gdn_norm_w = p.in[7];
    const float* w_out = p.in[8]; const float* ln2_w = p.in[9]; const float* peer_wq = p.in[10]; const float* peer_keys = p.in[11];
    const float* peer_u = p.in[12]; const float* peer_v = p.in[13]; const float* lnf_w = p.in[14];
    float* out = p.out; unsigned char* ws = p.ws;
    bf16_t* WinT = (bf16_t*)(ws + OFF_WIN); bf16_t* WoutT = (bf16_t*)(ws + OFF_WOUT); bf16_t* WqT = (bf16_t*)(ws + OFF_WQ); bf16_t* keysb = (bf16_t*)(ws + OFF_KEYS);
    float* r1 = (float*)(ws + OFF_R1); float* r2 = (float*)(ws + OFF_R2); float* gdec = (float*)(ws + OFF_GDEC); float* beta = (float*)(ws + OFF_BETA);
    bf16_t* xb = (bf16_t*)(ws + OFF_C); bf16_t* x2b = xb;
    bf16_t* projb = (bf16_t*)(ws + OFF_D); bf16_t* qp = projb;
    unsigned* top1 = (unsigned*)(ws + OFF_D + 64 * MiB); int* sel_id = (int*)(ws + OFF_D + 80 * MiB); float* sel_g = (float*)(ws + OFF_D + 88 * MiB);
    bf16_t* UT = (bf16_t*)(ws + OFF_E); bf16_t* mixed = UT; bf16_t* Wm = (bf16_t*)(ws + OFF_E + 16 * MiB); bf16_t* KstT = (bf16_t*)(ws + OFF_E + 32 * MiB);
    bf16_t* kn = (bf16_t*)(ws + OFF_E + 48 * MiB);
    bf16_t* VnT = (bf16_t*)(ws + OFF_C); bf16_t* Sst = (bf16_t*)(ws + OFF_C + 16 * MiB);
    float* gcb = (float*)(ws + OFF_GCB);
    float* o_r = out;
    bf16_t* rqr = (bf16_t*)((unsigned char*)out + 32 * MiB); bf16_t* rkr = (bf16_t*)((unsigned char*)out + 40 * MiB);

    GRID_LOOP(b, T_ / 4) k_prep_x(b, x, ln1_w, w_in, A_log, dt_bias, xb, r1, gdec, beta);
    GRID_LOOP(b, (NPROJ / 32) * 32) k_transpose(b % (NPROJ / 32), b / (NPROJ / 32), (float(*)[33])smem, w_in, LDWIN, ln1_w, WinT, 1024);
    GRID_LOOP(b, 32 * 32) k_transpose(b % 32, b / 32, (float(*)[33])smem, w_out, 1024, nullptr, WoutT, 1024);
    GRID_LOOP(b, 64 * 32) k_transpose(b % 64, b / 64, (float(*)[33])smem, peer_wq, 2048, ln2_w, WqT, 1024);
    GRID_LOOP(b, (16 * 128 * 128 / 4) / 256) k_convert(b, peer_keys, keysb, 16 * 128 * 128 / 4);
    grid.sync();
    GRID_LOOP(b, (T_ / 128) * (NPROJ / 128)) k_gemm<0>(b, smem, xb, 1024, WinT, 1024, 1024, projb, NPROJ, r1, NPROJ / 128);
    grid.sync();
    GRID_LOOP(b, 512) gdn_phaseA(b, smem, projb, conv_w, gdec, beta, UT, Wm, KstT, kn, gcb);
    GRID_LOOP(b, T_) k_rope(b, projb, rqr, rkr);
    grid.sync();
    if (blockIdx.x < 16) gdn_scan(blockIdx.x, smem, UT, Wm, KstT, gcb, VnT, Sst);
    else {
        const int gw = (blockIdx.x - 16) * 4 + (threadIdx.x >> 6);
        for (int w = gw; w < 512; w += (gridDim.x - 16) * 4) k_recur_ret(w, rqr, rkr, projb, o_r);
    }
    grid.sync();
    GRID_LOOP(b, 512) gdn_phaseC(b, smem, projb, conv_w, kn, gcb, VnT, Sst, gdn_norm_w, mixed);
    GRID_LOOP(b, T_) k_mixnorm_ret(b, o_r, projb, ret_norm_w, mixed);
    grid.sync();
    GRID_LOOP(b, (T_ / 128) * 8) k_gemm<1>(b, smem, mixed, 1024, WoutT, 1024, 1024, out, 1024, x, 8);
    grid.sync();
    GRID_LOOP(b, T_ / 4) k_rownorm2(b, out, x2b, r2);
    grid.sync();
    GRID_LOOP(b, (T_ / 128) * 16) k_gemm<0>(b, smem, x2b, 1024, WqT, 1024, 1024, qp, 2048, r2, 16);
    grid.sync();
    GRID_LOOP(b, (T_ / 128) * 16) k_scores_topk(b, smem, qp, keysb, top1);
    grid.sync();
    GRID_LOOP(b, T_ * 8 / 256) k_cand(b, top1, sel_id, sel_g);
    grid.sync();
    GRID_LOOP(b, T_ / 4) k_peer(b, out, r2, ln2_w, sel_id, sel_g, peer_u, peer_v, lnf_w, out);
}

extern "C" void kernel_launch(void* const* d_in, const int* in_sizes, int n_in, void* d_out, int out_size, void* d_ws, size_t ws_size, hipStream_t stream) {
    static int grid_blocks = 0;
    if (!grid_blocks) {
        int dev = 0, cus = 0, per_cu = 0;
        hipGetDevice(&dev);
        hipDeviceGetAttribute(&cus, hipDeviceAttributeMultiprocessorCount, dev);
        hipOccupancyMaxActiveBlocksPerMultiprocessor(&per_cu, mega, 256, 0);
        if (per_cu > 2) per_cu = 2;
        if (per_cu < 1) per_cu = 1;
        grid_blocks = cus * per_cu;
    }
    if (n_in < 15 || ws_size < WS_END) { fprintf(stderr, "kernel_launch: unexpected inputs / workspace (%d inputs, %zu bytes)\n", n_in, ws_size); return; }
    Params p{};
    for (int i = 0; i < 15; ++i) p.in[i] = (const float*)d_in[i];
    p.out = (float*)d_out; p.ws = (unsigned char*)d_ws;
    void* args[] = {&p};
    hipError_t e = hipLaunchCooperativeKernel((const void*)mega, dim3(grid_blocks), dim3(256), args, 0, stream);
    if (e != hipSuccess) fprintf(stderr, "cooperative launch failed: %s (grid %d)\n", hipGetErrorString(e), grid_blocks);
}
```

```cpp
#include <hip/hip_runtime.h>
#include <hip/hip_cooperative_groups.h>
#include <stdint.h>
#include <cstdio>
namespace cg = cooperative_groups;

typedef unsigned short bf16_t;
typedef __attribute__((ext_vector_type(8))) short bf16x8;
typedef __attribute__((ext_vector_type(4))) float f32x4;

constexpr int T_ = 16384;
constexpr int NPROJ = 3584;
constexpr int LDWIN = 3592;
constexpr float EPS = 1e-6f;

constexpr int C_RQ = 0, C_RK = 256, C_RV = 512, C_RG = 1024, C_GQ = 1536, C_GK = 2048, C_GV = 2560, C_GZ = 3072;

__constant__ double INVREV[32] = {0.15915494309189535, 0.11934937021124886, 0.08949940160889101, 0.06711508300522726, 0.050329212104487035, 0.03774158471741977, 0.0283021958306234, 0.02122365276477766, 0.015915494309189534, 0.011934937021124886, 0.0089499401608891, 0.006711508300522725, 0.005032921210448704, 0.003774158471741977, 0.00283021958306234, 0.002122365276477766, 0.0015915494309189536, 0.0011934937021124887, 0.0008949940160889102, 0.0006711508300522725, 0.0005032921210448703, 0.0003774158471741977, 0.00028302195830623395, 0.00021223652764777658, 0.00015915494309189535, 0.00011934937021124886, 8.9499401608891e-05, 6.711508300522725e-05, 5.0329212104487035e-05, 3.774158471741978e-05, 2.83021958306234e-05, 2.122365276477766e-05};

__device__ __forceinline__ bf16_t f2bf(float f) {
    unsigned u = __float_as_uint(f);
    u += 0x7fffu + ((u >> 16) & 1u);
    return (bf16_t)(u >> 16);
}
__device__ __forceinline__ float bf2f(bf16_t h) { return __uint_as_float(((unsigned)h) << 16); }
__device__ __forceinline__ float wave_sum(float v) {
#pragma unroll
    for (int o = 32; o > 0; o >>= 1) v += __shfl_xor(v, o);
    return v;
}
__device__ __forceinline__ float silu(float x) { return x / (1.f + __expf(-x)); }
__device__ __forceinline__ unsigned fkey(float f) { unsigned u = __float_as_uint(f); return (u & 0x80000000u) ? ~u : (u | 0x80000000u); }
__device__ __forceinline__ float keyf(unsigned k) { return __uint_as_float((k & 0x80000000u) ? (k & 0x7fffffffu) : ~k); }

__device__ __forceinline__ void k_prep_x(int bid, const float* __restrict__ x, const float* __restrict__ ln1_w, const float* __restrict__ w_in,
                                                const float* __restrict__ A_log, const float* __restrict__ dt_bias,
                                                bf16_t* __restrict__ xb, float* __restrict__ r1, float* __restrict__ gdec, float* __restrict__ beta) {
    const int wave = threadIdx.x >> 6, lane = threadIdx.x & 63;
    const int row = bid * 4 + wave;
    const float* xr = x + (size_t)row * 1024;
    float ss = 0.f;
    float g0 = 0, g1 = 0, g2 = 0, g3 = 0, g4 = 0, g5 = 0, g6 = 0, g7 = 0;
#pragma unroll
    for (int j = 0; j < 4; ++j) {
        const int c = j * 256 + lane * 4;
        const float4 v = *(const float4*)(xr + c);
        const float4 w = *(const float4*)(ln1_w + c);
        ss += v.x * v.x + v.y * v.y + v.z * v.z + v.w * v.w;
        ushort4 o; o.x = f2bf(v.x); o.y = f2bf(v.y); o.z = f2bf(v.z); o.w = f2bf(v.w);
        *(ushort4*)(xb + (size_t)row * 1024 + c) = o;
        const float xs[4] = {v.x * w.x, v.y * w.y, v.z * w.z, v.w * w.w};
#pragma unroll
        for (int e = 0; e < 4; ++e) {
            const float* wp = w_in + (size_t)(c + e) * LDWIN + NPROJ;
            const float4 a = *(const float4*)wp; const float4 b = *(const float4*)(wp + 4);
            g0 += xs[e] * a.x; g1 += xs[e] * a.y; g2 += xs[e] * a.z; g3 += xs[e] * a.w;
            g4 += xs[e] * b.x; g5 += xs[e] * b.y; g6 += xs[e] * b.z; g7 += xs[e] * b.w;
        }
    }
    ss = wave_sum(ss);
    g0 = wave_sum(g0); g1 = wave_sum(g1); g2 = wave_sum(g2); g3 = wave_sum(g3);
    g4 = wave_sum(g4); g5 = wave_sum(g5); g6 = wave_sum(g6); g7 = wave_sum(g7);
    const float r = rsqrtf(ss * (1.f / 1024.f) + EPS);
    if (lane == 0) {
        r1[row] = r;
        const float ga[4] = {g0 * r, g1 * r, g2 * r, g3 * r};
        const float gb[4] = {g4 * r, g5 * r, g6 * r, g7 * r};
#pragma unroll
        for (int h = 0; h < 4; ++h) {
            const float xx = ga[h] + dt_bias[h];
            const float sp = xx > 20.f ? xx : log1pf(expf(xx));
            gdec[row * 4 + h] = -expf(A_log[h]) * sp;
            beta[row * 4 + h] = 1.f / (1.f + expf(-gb[h]));
        }
    }
}

__device__ __forceinline__ void k_transpose(int bidx, int bidy, float (*tile)[33], const float* __restrict__ src, int ld, const float* __restrict__ scale, bf16_t* __restrict__ dst, int K) {
    const int n0 = bidx * 32, k0 = bidy * 32;
    const int tx = threadIdx.x & 31, ty = threadIdx.x >> 5;
#pragma unroll
    for (int j = 0; j < 4; ++j) {
        const int k = k0 + ty + 8 * j;
        const float s = scale ? scale[k] : 1.f;
        tile[ty + 8 * j][tx] = src[(size_t)k * ld + n0 + tx] * s;
    }
    __syncthreads();
#pragma unroll
    for (int j = 0; j < 4; ++j) {
        const int n = n0 + ty + 8 * j;
        dst[(size_t)n * K + k0 + tx] = f2bf(tile[tx][ty + 8 * j]);
    }
    __syncthreads();
}

__device__ __forceinline__ void k_convert(int bid, const float* __restrict__ src, bf16_t* __restrict__ dst, int n4) {
    const int i = bid * 256 + threadIdx.x;
    if (i < n4) {
        const float4 v = ((const float4*)src)[i];
        ushort4 o; o.x = f2bf(v.x); o.y = f2bf(v.y); o.z = f2bf(v.z); o.w = f2bf(v.w);
        ((ushort4*)dst)[i] = o;
    }
}

constexpr int GLD = 72;
template <int EPI>
__device__ __forceinline__ void k_gemm(int bid, unsigned char* smem, const bf16_t* __restrict__ A, int lda, const bf16_t* __restrict__ Bt, int ldb, int K,
                                              void* __restrict__ Cv, int ldc, const float* __restrict__ aux, int ntn) {
    bf16_t (*As)[128][GLD] = (bf16_t(*)[128][GLD])smem;
    bf16_t (*Bs)[128][GLD] = (bf16_t(*)[128][GLD])(smem + 2 * 128 * GLD * 2);
    const int tid = threadIdx.x, lane = tid & 63, w = tid >> 6;
    const int wr = w >> 1, wc = w & 1, r = lane & 15, quad = lane >> 4;
    const int tm = bid / ntn, tn = bid % ntn;
    const int m0 = tm * 128, n0 = tn * 128;
    const bf16_t* Ag = A + (size_t)m0 * lda;
    const bf16_t* Bg = Bt + (size_t)n0 * ldb;
    f32x4 acc[4][4];
#pragma unroll
    for (int i = 0; i < 4; ++i)
#pragma unroll
        for (int j = 0; j < 4; ++j) acc[i][j] = (f32x4){0.f, 0.f, 0.f, 0.f};
    uint4 ra[4], rb[4];
    const int nk = K / 64;
#pragma unroll
    for (int j = 0; j < 4; ++j) {
        const int c = tid + 256 * j, row = c >> 3, cc = c & 7;
        ra[j] = *(const uint4*)(Ag + (size_t)row * lda + cc * 8);
        rb[j] = *(const uint4*)(Bg + (size_t)row * ldb + cc * 8);
    }
#pragma unroll
    for (int j = 0; j < 4; ++j) {
        const int c = tid + 256 * j, row = c >> 3, cc = c & 7;
        *(uint4*)&As[0][row][cc * 8] = ra[j];
        *(uint4*)&Bs[0][row][cc * 8] = rb[j];
    }
    __syncthreads();
    for (int kt = 0; kt < nk; ++kt) {
        const int buf = kt & 1;
        const int kn = (kt + 1 < nk) ? kt + 1 : kt;
#pragma unroll
        for (int j = 0; j < 4; ++j) {
            const int c = tid + 256 * j, row = c >> 3, cc = c & 7;
            ra[j] = *(const uint4*)(Ag + (size_t)row * lda + kn * 64 + cc * 8);
            rb[j] = *(const uint4*)(Bg + (size_t)row * ldb + kn * 64 + cc * 8);
        }
        const bf16_t (*Ab)[GLD] = As[buf];
        const bf16_t (*Bb)[GLD] = Bs[buf];
#pragma unroll
        for (int ks = 0; ks < 2; ++ks) {
            bf16x8 a[4], b[4];
#pragma unroll
            for (int i = 0; i < 4; ++i) a[i] = *(const bf16x8*)&Ab[wr * 64 + i * 16 + r][ks * 32 + quad * 8];
#pragma unroll
            for (int j = 0; j < 4; ++j) b[j] = *(const bf16x8*)&Bb[wc * 64 + j * 16 + r][ks * 32 + quad * 8];
#pragma unroll
            for (int i = 0; i < 4; ++i)
#pragma unroll
                for (int j = 0; j < 4; ++j) acc[i][j] = __builtin_amdgcn_mfma_f32_16x16x32_bf16(b[j], a[i], acc[i][j], 0, 0, 0);
        }
        bf16_t (*An)[GLD] = As[buf ^ 1];
        bf16_t (*Bn)[GLD] = Bs[buf ^ 1];
#pragma unroll
        for (int j = 0; j < 4; ++j) {
            const int c = tid + 256 * j, row = c >> 3, cc = c & 7;
            *(uint4*)&An[row][cc * 8] = ra[j];
            *(uint4*)&Bn[row][cc * 8] = rb[j];
        }
        __syncthreads();
    }
#pragma unroll
    for (int i = 0; i < 4; ++i) {
        const int row = m0 + wr * 64 + i * 16 + r;
        float rs = 1.f;
        if (EPI == 0) rs = aux[row];
#pragma unroll
        for (int j = 0; j < 4; ++j) {
            const int col = n0 + wc * 64 + j * 16 + quad * 4;
            if (EPI == 0) {
                ushort4 o; o.x = f2bf(acc[i][j][0] * rs); o.y = f2bf(acc[i][j][1] * rs); o.z = f2bf(acc[i][j][2] * rs); o.w = f2bf(acc[i][j][3] * rs);
                *(ushort4*)((bf16_t*)Cv + (size_t)row * ldc + col) = o;
            } else {
                const float4 xr = *(const float4*)(aux + (size_t)row * ldc + col);
                float4 o; o.x = xr.x + acc[i][j][0]; o.y = xr.y + acc[i][j][1]; o.z = xr.z + acc[i][j][2]; o.w = xr.w + acc[i][j][3];
                *(float4*)((float*)Cv + (size_t)row * ldc + col) = o;
            }
        }
    }
}

__device__ __forceinline__ void k_preproc(int bid, const bf16_t* __restrict__ projb, const float* __restrict__ conv_w,
                                                 bf16_t* __restrict__ rqr, bf16_t* __restrict__ rkr,
                                                 bf16_t* __restrict__ cq, bf16_t* __restrict__ ck, bf16_t* __restrict__ cv) {
    const int t = bid, tid = threadIdx.x;
    {
        const int which = tid >> 7, h = (tid >> 5) & 3, j = tid & 31;
        const bf16_t* p = projb + (size_t)t * NPROJ + which * 256 + h * 64;
        const float a = bf2f(p[j]), b = bf2f(p[j + 32]);
        double u = (double)t * INVREV[j];
        u -= rint(u);
        const float fr = (float)u;
        const float sn = __builtin_amdgcn_sinf(fr), cs = __builtin_amdgcn_cosf(fr);
        const float sc = which ? 0.125f : 1.f;
        bf16_t* o = (which ? rkr : rqr) + (size_t)t * 256 + h * 64;
        o[j] = f2bf((a * cs - b * sn) * sc);
        o[j + 32] = f2bf((a * sn + b * cs) * sc);
    }
    {
        const int h = tid >> 6, l = tid & 63;
        float vals[3][2];
#pragma unroll
        for (int part = 0; part < 3; ++part)
#pragma unroll
            for (int e = 0; e < 2; ++e) {
                const int c = part * 512 + h * 128 + 2 * l + e;
                float acc = 0.f;
#pragma unroll
                for (int j = 0; j < 4; ++j) {
                    const int tt = t - 3 + j;
                    if (tt >= 0) acc += conv_w[j * 1536 + c] * bf2f(projb[(size_t)tt * NPROJ + C_GQ + c]);
                }
                vals[part][e] = silu(acc);
            }
        const float sq = wave_sum(vals[0][0] * vals[0][0] + vals[0][1] * vals[0][1]);
        const float sk = wave_sum(vals[1][0] * vals[1][0] + vals[1][1] * vals[1][1]);
        const float rq = rsqrtf(sq + EPS), rk = rsqrtf(sk + EPS);
        const size_t o = (size_t)t * 512 + h * 128 + 2 * l;
        cq[o] = f2bf(vals[0][0] * rq); cq[o + 1] = f2bf(vals[0][1] * rq);
        ck[o] = f2bf(vals[1][0] * rk); ck[o + 1] = f2bf(vals[1][1] * rk);
        cv[o] = f2bf(vals[2][0]); cv[o + 1] = f2bf(vals[2][1]);
    }
}

__device__ __forceinline__ void k_recur_ret(int bid, const bf16_t* __restrict__ rqr, const bf16_t* __restrict__ rkr, const bf16_t* __restrict__ projb, float* __restrict__ o_r) {
    const int h = bid >> 7, e = bid & 127, lane = threadIdx.x & 63;
    const float gamma = 1.f - exp2f(-5.f - (float)h);
    float s = 0.f;
    const bf16_t* qp = rqr + h * 64 + lane;
    const bf16_t* kp = rkr + h * 64 + lane;
    const bf16_t* vp = projb + C_RV + h * 128 + e;
    for (int t0 = 0; t0 < T_; t0 += 8) {
        float k[8], q[8], v[8];
#pragma unroll
        for (int i = 0; i < 8; ++i) {
            k[i] = bf2f(kp[(size_t)(t0 + i) * 256]);
            q[i] = bf2f(qp[(size_t)(t0 + i) * 256]);
            v[i] = bf2f(vp[(size_t)(t0 + i) * NPROJ]);
        }
#pragma unroll
        for (int i = 0; i < 8; ++i) {
            s = gamma * s + k[i] * v[i];
            const float p = wave_sum(q[i] * s);
            if (lane == 0) o_r[(size_t)(t0 + i) * 512 + h * 128 + e] = p;
        }
    }
}

__device__ __forceinline__ void k_recur_gdn(int bid, const bf16_t* __restrict__ cq, const bf16_t* __restrict__ ck, const bf16_t* __restrict__ cv,
                                                  const float* __restrict__ gdec, const float* __restrict__ beta, float* __restrict__ o_g) {
    const int h = bid >> 7, e = bid & 127, lane = threadIdx.x & 63;
    float s0 = 0.f, s1 = 0.f;
    const bf16_t* qp = cq + h * 128 + 2 * lane;
    const bf16_t* kp = ck + h * 128 + 2 * lane;
    const bf16_t* vp = cv + h * 128 + e;
    for (int t0 = 0; t0 < T_; t0 += 8) {
        float k0[8], k1[8], q0[8], q1[8], v[8], a[8], b[8];
#pragma unroll
        for (int i = 0; i < 8; ++i) {
            const size_t t = t0 + i;
            k0[i] = bf2f(kp[t * 512]); k1[i] = bf2f(kp[t * 512 + 1]);
            q0[i] = bf2f(qp[t * 512]); q1[i] = bf2f(qp[t * 512 + 1]);
            v[i] = bf2f(vp[t * 512]);
            a[i] = __expf(gdec[t * 4 + h]);
            b[i] = beta[t * 4 + h];
        }
#pragma unroll
        for (int i = 0; i < 8; ++i) {
            const float ks = wave_sum(k0[i] * s0 + k1[i] * s1);
            const float coef = b[i] * (v[i] - a[i] * ks);
            s0 = a[i] * s0 + coef * k0[i];
            s1 = a[i] * s1 + coef * k1[i];
            const float o = wave_sum(q0[i] * s0 + q1[i] * s1) * 0.08838834764831845f;
            if (lane == 0) o_g[(size_t)(t0 + i) * 512 + h * 128 + e] = o;
        }
    }
}

__device__ __forceinline__ void k_mixnorm(int bid, const float* __restrict__ o_r, const float* __restrict__ o_g, const bf16_t* __restrict__ projb,
                                                 const float* __restrict__ ret_norm_w, const float* __restrict__ gdn_norm_w, bf16_t* __restrict__ mixed) {
    const int gw = bid * 4 + (threadIdx.x >> 6), l = threadIdx.x & 63;
    const int t = gw >> 3, g = gw & 7;
    if (g < 4) {
        const float2 o = *(const float2*)(o_r + (size_t)t * 512 + g * 128 + 2 * l);
        const float mu = wave_sum(o.x + o.y) * (1.f / 128.f);
        const float d0 = o.x - mu, d1 = o.y - mu;
        const float var = wave_sum(d0 * d0 + d1 * d1) * (1.f / 128.f);
        const float rs = rsqrtf(var + EPS);
        const bf16_t* gp = projb + (size_t)t * NPROJ + C_RG + g * 128 + 2 * l;
        const float y0 = d0 * rs * ret_norm_w[g * 128 + 2 * l] * silu(bf2f(gp[0]));
        const float y1 = d1 * rs * ret_norm_w[g * 128 + 2 * l + 1] * silu(bf2f(gp[1]));
        bf16_t* mp = mixed + (size_t)t * 1024 + g * 128 + 2 * l;
        mp[0] = f2bf(y0); mp[1] = f2bf(y1);
    } else {
        const int h = g - 4;
        const float2 o = *(const float2*)(o_g + (size_t)t * 512 + h * 128 + 2 * l);
        const float ms = wave_sum(o.x * o.x + o.y * o.y) * (1.f / 128.f);
        const float rs = rsqrtf(ms + EPS);
        const bf16_t* gp = projb + (size_t)t * NPROJ + C_GZ + h * 128 + 2 * l;
        const float y0 = o.x * rs * gdn_norm_w[2 * l] * silu(bf2f(gp[0]));
        const float y1 = o.y * rs * gdn_norm_w[2 * l + 1] * silu(bf2f(gp[1]));
        bf16_t* mp = mixed + (size_t)t * 1024 + 512 + h * 128 + 2 * l;
        mp[0] = f2bf(y0); mp[1] = f2bf(y1);
    }
}

__device__ __forceinline__ void k_rownorm2(int bid, const float* __restrict__ x2, bf16_t* __restrict__ x2b, float* __restrict__ r2) {
    const int row = bid * 4 + (threadIdx.x >> 6), lane = threadIdx.x & 63;
    float ss = 0.f;
#pragma unroll
    for (int j = 0; j < 4; ++j) {
        const int c = j * 256 + lane * 4;
        const float4 v = *(const float4*)(x2 + (size_t)row * 1024 + c);
        ss += v.x * v.x + v.y * v.y + v.z * v.z + v.w * v.w;
        ushort4 o; o.x = f2bf(v.x); o.y = f2bf(v.y); o.z = f2bf(v.z); o.w = f2bf(v.w);
        *(ushort4*)(x2b + (size_t)row * 1024 + c) = o;
    }
    ss = wave_sum(ss);
    if (lane == 0) r2[row] = rsqrtf(ss * (1.f / 1024.f) + EPS);
}

constexpr int SLD = 136;
__device__ __forceinline__ void k_scores_topk(int bid, unsigned char* smem, const bf16_t* __restrict__ qp, const bf16_t* __restrict__ keysb, unsigned* __restrict__ top1) {
    bf16_t (*As)[SLD] = (bf16_t(*)[SLD])smem;
    bf16_t (*Bs)[SLD] = (bf16_t(*)[SLD])(smem + 128 * SLD * 2);
    unsigned (*S)[129] = (unsigned(*)[129])smem;
    const int tid = threadIdx.x, lane = tid & 63, w = tid >> 6;
    const int wr = w >> 1, wc = w & 1, r = lane & 15, quad = lane >> 4;
    const int hp = bid & 15, t0 = (bid >> 4) * 128;
#pragma unroll
    for (int j = 0; j < 8; ++j) {
        const int c = tid + 256 * j, row = c >> 4, cc = c & 15;
        *(uint4*)&As[row][cc * 8] = *(const uint4*)(qp + (size_t)(t0 + row) * 2048 + hp * 128 + cc * 8);
        *(uint4*)&Bs[row][cc * 8] = *(const uint4*)(keysb + (size_t)hp * 16384 + row * 128 + cc * 8);
    }
    __syncthreads();
    f32x4 acc[4][4];
#pragma unroll
    for (int i = 0; i < 4; ++i)
#pragma unroll
        for (int j = 0; j < 4; ++j) acc[i][j] = (f32x4){0.f, 0.f, 0.f, 0.f};
#pragma unroll
    for (int ks = 0; ks < 4; ++ks) {
        bf16x8 a[4], b[4];
#pragma unroll
        for (int i = 0; i < 4; ++i) a[i] = *(const bf16x8*)&As[wr * 64 + i * 16 + r][ks * 32 + quad * 8];
#pragma unroll
        for (int j = 0; j < 4; ++j) b[j] = *(const bf16x8*)&Bs[wc * 64 + j * 16 + r][ks * 32 + quad * 8];
#pragma unroll
        for (int i = 0; i < 4; ++i)
#pragma unroll
            for (int j = 0; j < 4; ++j) acc[i][j] = __builtin_amdgcn_mfma_f32_16x16x32_bf16(b[j], a[i], acc[i][j], 0, 0, 0);
    }
    __syncthreads();
#pragma unroll
    for (int i = 0; i < 4; ++i)
#pragma unroll
        for (int j = 0; j < 4; ++j)
#pragma unroll
            for (int v = 0; v < 4; ++v) {
                const int row = wr * 64 + i * 16 + r, col = wc * 64 + j * 16 + quad * 4 + v;
                S[row][col] = (fkey(acc[i][j][v]) & ~0x7Fu) | (unsigned)col;
            }
    __syncthreads();
    if (tid < 128) {
        unsigned top[16];
#pragma unroll
        for (int i = 0; i < 16; ++i) top[i] = 0u;
        for (int c = 0; c < 128; ++c) {
            const unsigned v = S[tid][c];
            if (v > top[15]) {
                top[15] = v;
#pragma unroll
                for (int i = 15; i > 0; --i) {
                    const unsigned hi = max(top[i - 1], top[i]), lo = min(top[i - 1], top[i]);
                    top[i - 1] = hi; top[i] = lo;
                }
            }
        }
        unsigned* o = top1 + ((size_t)(t0 + tid) * 16 + hp) * 16;
#pragma unroll
        for (int i = 0; i < 4; ++i) *(uint4*)(o + 4 * i) = make_uint4(top[4 * i], top[4 * i + 1], top[4 * i + 2], top[4 * i + 3]);
    }
    __syncthreads();
}

__device__ __forceinline__ void k_cand(int bid, const unsigned* __restrict__ top1, int* __restrict__ sel_id, float* __restrict__ sel_g) {
    const int gid = bid * 256 + threadIdx.x;
    const int t = gid >> 3, h = gid & 7;
    const unsigned* p0 = top1 + ((size_t)t * 16 + h * 2) * 16;
    const unsigned* p1 = p0 + 16;
    float s1[16], s2[16];
#pragma unroll
    for (int i = 0; i < 4; ++i) {
        const uint4 a = *(const uint4*)(p0 + 4 * i), b = *(const uint4*)(p1 + 4 * i);
        s1[4 * i] = keyf(a.x & ~0x7Fu); s1[4 * i + 1] = keyf(a.y & ~0x7Fu); s1[4 * i + 2] = keyf(a.z & ~0x7Fu); s1[4 * i + 3] = keyf(a.w & ~0x7Fu);
        s2[4 * i] = keyf(b.x & ~0x7Fu); s2[4 * i + 1] = keyf(b.y & ~0x7Fu); s2[4 * i + 2] = keyf(b.z & ~0x7Fu); s2[4 * i + 3] = keyf(b.w & ~0x7Fu);
    }
    unsigned top[16];
#pragma unroll
    for (int i = 0; i < 16; ++i) top[i] = 0u;
#pragma unroll
    for (int a = 0; a < 16; ++a)
#pragma unroll
        for (int b = 0; b < 16; ++b)
            if ((a + 1) * (b + 1) <= 16) {
                const unsigned v = (fkey(s1[a] + s2[b]) & ~0xFFu) | (unsigned)(a * 16 + b);
                if (v > top[15]) {
                    top[15] = v;
#pragma unroll
                    for (int i = 15; i > 0; --i) {
                        const unsigned hi = max(top[i - 1], top[i]), lo = min(top[i - 1], top[i]);
                        top[i - 1] = hi; top[i] = lo;
                    }
                }
            }
    float ex[16], sum = 0.f;
    const float m = keyf(top[0] & ~0xFFu);
#pragma unroll
    for (int i = 0; i < 16; ++i) { ex[i] = __expf(keyf(top[i] & ~0xFFu) - m); sum += ex[i]; }
    const float inv = 1.f / sum;
#pragma unroll
    for (int i = 0; i < 16; ++i) {
        const int ab = top[i] & 0xFF;
        const int i1 = p0[ab >> 4] & 0x7F, i2 = p1[ab & 15] & 0x7F;
        sel_id[(size_t)t * 128 + h * 16 + i] = i1 * 128 + i2;
        sel_g[(size_t)t * 128 + h * 16 + i] = ex[i] * inv;
    }
}

__device__ __forceinline__ void k_peer(int bid, const float* x2, const float* __restrict__ r2, const float* __restrict__ ln2_w,
                                              const int* __restrict__ sel_id, const float* __restrict__ sel_g,
                                              const float* __restrict__ peer_u, const float* __restrict__ peer_v, const float* __restrict__ lnf_w,
                                              float* out) {
    const int t = bid * 4 + (threadIdx.x >> 6), lane = threadIdx.x & 63;
    float4 xv[4], h2[4], acc[4];
    const float rr = r2[t];
#pragma unroll
    for (int j = 0; j < 4; ++j) {
        const int c = j * 256 + lane * 4;
        xv[j] = *(const float4*)(x2 + (size_t)t * 1024 + c);
        const float4 w = *(const float4*)(ln2_w + c);
        h2[j] = make_float4(xv[j].x * rr * w.x, xv[j].y * rr * w.y, xv[j].z * rr * w.z, xv[j].w * rr * w.w);
        acc[j] = make_float4(0.f, 0.f, 0.f, 0.f);
    }
    const int id0 = sel_id[(size_t)t * 128 + lane], id1 = sel_id[(size_t)t * 128 + 64 + lane];
    const float gg0 = sel_g[(size_t)t * 128 + lane], gg1 = sel_g[(size_t)t * 128 + 64 + lane];
    for (int half = 0; half < 2; ++half) {
        const int idv = half ? id1 : id0;
        const float gv = half ? gg1 : gg0;
#pragma unroll 4
        for (int k = 0; k < 64; ++k) {
            const int id = __builtin_amdgcn_readlane(idv, k);
            const float gate = __uint_as_float(__builtin_amdgcn_readlane(__float_as_uint(gv), k));
            const float* ur = peer_u + (size_t)id * 1024 + lane * 4;
            float d = 0.f;
#pragma unroll
            for (int j = 0; j < 4; ++j) {
                const float4 u4 = *(const float4*)(ur + 256 * j);
                d += u4.x * h2[j].x + u4.y * h2[j].y + u4.z * h2[j].z + u4.w * h2[j].w;
            }
            d = wave_sum(d);
            const float c = gate * 0.5f * d * (1.f + erff(d * 0.70710678118654752f));
            const float* vr = peer_v + (size_t)id * 1024 + lane * 4;
#pragma unroll
            for (int j = 0; j < 4; ++j) {
                const float4 v4 = *(const float4*)(vr + 256 * j);
                acc[j].x += c * v4.x; acc[j].y += c * v4.y; acc[j].z += c * v4.z; acc[j].w += c * v4.w;
            }
        }
    }
    float ss = 0.f;
#pragma unroll
    for (int j = 0; j < 4; ++j) {
        acc[j].x += xv[j].x; acc[j].y += xv[j].y; acc[j].z += xv[j].z; acc[j].w += xv[j].w;
        ss += acc[j].x * acc[j].x + acc[j].y * acc[j].y + acc[j].z * acc[j].z + acc[j].w * acc[j].w;
    }
    ss = wave_sum(ss);
    const float rs = rsqrtf(ss * (1.f / 1024.f) + EPS);
#pragma unroll
    for (int j = 0; j < 4; ++j) {
        const int c = j * 256 + lane * 4;
        const float4 w = *(const float4*)(lnf_w + c);
        *(float4*)(out + (size_t)t * 1024 + c) = make_float4(acc[j].x * rs * w.x, acc[j].y * rs * w.y, acc[j].z * rs * w.z, acc[j].w * rs * w.w);
    }
}

constexpr int LDT = 136;
constexpr float QSCALE = 0.08838834764831845f;
constexpr size_t CH = 128 * 128;

__device__ __forceinline__ f32x4 mfma16(bf16x8 a, bf16x8 b, f32x4 c) { return __builtin_amdgcn_mfma_f32_16x16x32_bf16(a, b, c, 0, 0, 0); }
__device__ __forceinline__ uint2 pack4(float a, float b, float c, float d) {
    uint2 r; r.x = (unsigned)f2bf(a) | ((unsigned)f2bf(b) << 16); r.y = (unsigned)f2bf(c) | ((unsigned)f2bf(d) << 16); return r;
}
__device__ __forceinline__ int lrow(int i) {
    const int m = i - 1, a = m >> 2, b = m & 3;
    return i <= 0 ? 0 : 8 * a * (a + 1) + 4 * b * (a + 1);
}
constexpr int LROW_TOTAL = 8320;

__device__ __forceinline__ void conv_norm_rows(const bf16_t* __restrict__ projb, int t0, int colbase, const float* cw, bf16_t (*tile)[LDT], bf16_t* gout) {
    const int tid = threadIdx.x, i = tid >> 1, hf = tid & 1;
    float vals[64];
    float ss = 0.f;
#pragma unroll
    for (int g = 0; g < 8; ++g) {
        float acc[8];
#pragma unroll
        for (int k = 0; k < 8; ++k) acc[k] = 0.f;
#pragma unroll
        for (int j = 0; j < 4; ++j) {
            const int tt = t0 + i - 3 + j;
            if (tt >= 0) {
                const uint4 raw = *(const uint4*)(projb + (size_t)tt * NPROJ + colbase + hf * 64 + g * 8);
                const float4 w0 = *(const float4*)(cw + j * 128 + hf * 64 + g * 8), w1 = *(const float4*)(cw + j * 128 + hf * 64 + g * 8 + 4);
                acc[0] += w0.x * __uint_as_float(raw.x << 16); acc[1] += w0.y * __uint_as_float(raw.x & 0xffff0000u);
                acc[2] += w0.z * __uint_as_float(raw.y << 16); acc[3] += w0.w * __uint_as_float(raw.y & 0xffff0000u);
                acc[4] += w1.x * __uint_as_float(raw.z << 16); acc[5] += w1.y * __uint_as_float(raw.z & 0xffff0000u);
                acc[6] += w1.z * __uint_as_float(raw.w << 16); acc[7] += w1.w * __uint_as_float(raw.w & 0xffff0000u);
            }
        }
#pragma unroll
        for (int k = 0; k < 8; ++k) { const float s = silu(acc[k]); vals[g * 8 + k] = s; ss += s * s; }
    }
    ss += __shfl_xor(ss, 1);
    const float rs = rsqrtf(ss + EPS);
#pragma unroll
    for (int g = 0; g < 8; ++g) {
        const uint2 p0 = pack4(vals[g * 8] * rs, vals[g * 8 + 1] * rs, vals[g * 8 + 2] * rs, vals[g * 8 + 3] * rs);
        const uint2 p1 = pack4(vals[g * 8 + 4] * rs, vals[g * 8 + 5] * rs, vals[g * 8 + 6] * rs, vals[g * 8 + 7] * rs);
        const uint4 o = make_uint4(p0.x, p0.y, p1.x, p1.y);
        *(uint4*)&tile[i][hf * 64 + g * 8] = o;
        if (gout) *(uint4*)(gout + (size_t)(t0 + i) * 512 + hf * 64 + g * 8) = o;
    }
}

__device__ __forceinline__ void gdn_phaseA(int item, unsigned char* smem, const bf16_t* __restrict__ projb, const float* __restrict__ conv_w,
                                           const float* __restrict__ gdec, const float* __restrict__ beta,
                                           bf16_t* __restrict__ UT, bf16_t* __restrict__ Wm, bf16_t* __restrict__ KstT, bf16_t* __restrict__ kn, float* __restrict__ gcb) {
    const int h = item & 3, n = item >> 2, t0 = n * 128;
    const int tid = threadIdx.x, lane = tid & 63, w = tid >> 6;
    { int zoff = 0; asm volatile("" : "+s"(zoff)); smem += zoff; }
    float* gs = (float*)smem;
    float* gcs = gs + 128;
    float* bts = gcs + 128;
    float* cw = bts + 128;
    float* Lp = cw + 512;
    bf16_t (*Kt)[LDT] = (bf16_t(*)[LDT])(smem + 3584 + LROW_TOTAL * 4);
    if (tid < 128) { gs[tid] = gdec[(size_t)(t0 + tid) * 4 + h]; bts[tid] = beta[(size_t)(t0 + tid) * 4 + h]; }
    for (int u = tid; u < 512; u += 256) cw[u] = conv_w[(u >> 7) * 1536 + 512 + h * 128 + (u & 127)];
    __syncthreads();
    if (tid < 128) {
        float s = 0.f;
        for (int j = 0; j <= tid; ++j) s += gs[j];
        gcs[tid] = s;
        gcb[(size_t)(h * 128 + n) * 128 + tid] = s;
    }
    conv_norm_rows(projb, t0, C_GK + h * 128, cw, Kt, kn + h * 128);
    __syncthreads();
    {
        const int wr = w >> 1, wc = w & 1, r = lane & 15, quad = lane >> 4;
        if (!(wr == 0 && wc == 1)) {
            f32x4 acc[4][4];
#pragma unroll
            for (int i = 0; i < 4; ++i)
#pragma unroll
                for (int j = 0; j < 4; ++j) acc[i][j] = (f32x4){0.f, 0.f, 0.f, 0.f};
#pragma unroll
            for (int ks = 0; ks < 4; ++ks) {
                bf16x8 a[4], b[4];
#pragma unroll
                for (int i = 0; i < 4; ++i) a[i] = *(const bf16x8*)&Kt[wr * 64 + i * 16 + r][ks * 32 + quad * 8];
#pragma unroll
                for (int j = 0; j < 4; ++j) b[j] = *(const bf16x8*)&Kt[wc * 64 + j * 16 + r][ks * 32 + quad * 8];
#pragma unroll
                for (int i = 0; i < 4; ++i)
#pragma unroll
                    for (int j = 0; j < 4; ++j) acc[i][j] = mfma16(b[j], a[i], acc[i][j]);
            }
#pragma unroll
            for (int i = 0; i < 4; ++i) {
                const int row = wr * 64 + i * 16 + r;
                const float bi = bts[row], gi = gcs[row];
                const int rs = lrow(row);
#pragma unroll
                for (int j = 0; j < 4; ++j) {
                    const int c0 = wc * 64 + j * 16 + quad * 4;
                    if (c0 < row) {
                        float4 o;
                        o.x = (c0 + 0 < row) ? bi * acc[i][j][0] * __expf(gi - gcs[c0 + 0]) : 0.f;
                        o.y = (c0 + 1 < row) ? bi * acc[i][j][1] * __expf(gi - gcs[c0 + 1]) : 0.f;
                        o.z = (c0 + 2 < row) ? bi * acc[i][j][2] * __expf(gi - gcs[c0 + 2]) : 0.f;
                        o.w = (c0 + 3 < row) ? bi * acc[i][j][3] * __expf(gi - gcs[c0 + 3]) : 0.f;
                        *(float4*)&Lp[rs + c0] = o;
                    }
                }
            }
        }
    }
    __syncthreads();
    float x[128];
    const size_t cbase = (size_t)(h * 128 + n) * CH;
    if (tid < 128) {
        const int e = tid;
        const bf16_t* vp = projb + C_GV + h * 128 + e;
        const float w0 = conv_w[0 * 1536 + 1024 + h * 128 + e], w1 = conv_w[1 * 1536 + 1024 + h * 128 + e];
        const float w2 = conv_w[2 * 1536 + 1024 + h * 128 + e], w3 = conv_w[3 * 1536 + 1024 + h * 128 + e];
        float r0 = (t0 >= 3) ? bf2f(vp[(size_t)(t0 - 3) * NPROJ]) : 0.f;
        float r1 = (t0 >= 2) ? bf2f(vp[(size_t)(t0 - 2) * NPROJ]) : 0.f;
        float r2 = (t0 >= 1) ? bf2f(vp[(size_t)(t0 - 1) * NPROJ]) : 0.f;
#pragma unroll
        for (int i = 0; i < 128; ++i) {
            const float r3 = bf2f(vp[(size_t)(t0 + i) * NPROJ]);
            x[i] = bts[i] * silu(w0 * r0 + w1 * r1 + w2 * r2 + w3 * r3);
            r0 = r1; r1 = r2; r2 = r3;
        }
    } else {
        const int d = tid - 128;
#pragma unroll
        for (int i = 0; i < 128; ++i) x[i] = bts[i] * __expf(gcs[i]) * bf2f(Kt[i][d]);
    }
    int zo = 0;
#pragma unroll
    for (int i = 1; i < 128; ++i) {
        float s = x[i];
        asm volatile("" : "+v"(zo) : "v"(x[i - 1]));
        const float* Lr = Lp + zo;
#pragma unroll
        for (int g = 0; g < (i + 3) / 4; ++g) {
            const float4 l = *(const float4*)&Lr[lrow(i) + 4 * g];
            if (4 * g + 0 < i) s -= l.x * x[4 * g + 0];
            if (4 * g + 1 < i) s -= l.y * x[4 * g + 1];
            if (4 * g + 2 < i) s -= l.z * x[4 * g + 2];
            if (4 * g + 3 < i) s -= l.w * x[4 * g + 3];
        }
        x[i] = s;
    }
    if (tid < 128) {
        bf16_t* up = UT + cbase + (size_t)tid * 128;
#pragma unroll
        for (int g = 0; g < 16; ++g) {
            const uint2 p0 = pack4(x[8 * g], x[8 * g + 1], x[8 * g + 2], x[8 * g + 3]), p1 = pack4(x[8 * g + 4], x[8 * g + 5], x[8 * g + 6], x[8 * g + 7]);
            *(uint4*)(up + 8 * g) = make_uint4(p0.x, p0.y, p1.x, p1.y);
        }
    } else {
        const int d = tid - 128;
        const float gl = gcs[127];
        bf16_t* kp = KstT + cbase + (size_t)d * 128;
#pragma unroll
        for (int g = 0; g < 16; ++g) {
            float kv[8];
#pragma unroll
            for (int k = 0; k < 8; ++k) kv[k] = bf2f(Kt[8 * g + k][d]) * __expf(gl - gcs[8 * g + k]);
            const uint2 p0 = pack4(kv[0], kv[1], kv[2], kv[3]), p1 = pack4(kv[4], kv[5], kv[6], kv[7]);
            *(uint4*)(kp + 8 * g) = make_uint4(p0.x, p0.y, p1.x, p1.y);
        }
    }
    __syncthreads();
    if (tid >= 128) {
        const int d = tid - 128;
#pragma unroll
        for (int i = 0; i < 128; ++i) Kt[i][d] = f2bf(x[i]);
    }
    __syncthreads();
#pragma unroll
    for (int j = 0; j < 8; ++j) {
        const int c = tid + 256 * j, row = c >> 4, cc = c & 15;
        *(uint4*)(Wm + cbase + (size_t)row * 128 + cc * 8) = *(const uint4*)&Kt[row][cc * 8];
    }
    __syncthreads();
}

struct ScanFrags { bf16x8 aw[2][4]; bf16x8 ak[2][4]; uint2 u[2][2]; float dec; };
__device__ __forceinline__ void scan_load(ScanFrags& f, int h, int n, int c, int w, int r, int quad,
                                          const bf16_t* __restrict__ UT, const bf16_t* __restrict__ Wm, const bf16_t* __restrict__ KstT, const float* __restrict__ gcb) {
    const size_t cbase = (size_t)(h * 128 + n) * CH;
#pragma unroll
    for (int mt = 0; mt < 2; ++mt)
#pragma unroll
        for (int ks = 0; ks < 4; ++ks) {
            const size_t o = cbase + (size_t)(32 * w + 16 * mt + r) * 128 + ks * 32 + quad * 8;
            f.aw[mt][ks] = *(const bf16x8*)(Wm + o);
            f.ak[mt][ks] = *(const bf16x8*)(KstT + o);
        }
#pragma unroll
    for (int mt = 0; mt < 2; ++mt)
#pragma unroll
        for (int nt = 0; nt < 2; ++nt)
            f.u[mt][nt] = *(const uint2*)(UT + cbase + (size_t)(32 * c + 16 * nt + r) * 128 + 32 * w + 16 * mt + quad * 4);
    f.dec = __expf(gcb[(size_t)(h * 128 + n) * 128 + 127]);
}
__device__ __forceinline__ void scan_step(const ScanFrags& f, f32x4 (&s)[2][2], int h, int n, int c, int w, int r, int quad,
                                          bf16_t (*ST)[LDT], bf16_t (*VT)[LDT], bf16_t* __restrict__ VnT, bf16_t* __restrict__ Sst) {
    f32x4 xa[2][2];
#pragma unroll
    for (int mt = 0; mt < 2; ++mt)
#pragma unroll
        for (int nt = 0; nt < 2; ++nt) xa[mt][nt] = (f32x4){0.f, 0.f, 0.f, 0.f};
#pragma unroll
    for (int ks = 0; ks < 4; ++ks) {
        const bf16x8 b0 = *(const bf16x8*)&ST[r][ks * 32 + quad * 8], b1 = *(const bf16x8*)&ST[16 + r][ks * 32 + quad * 8];
#pragma unroll
        for (int mt = 0; mt < 2; ++mt) { xa[mt][0] = mfma16(f.aw[mt][ks], b0, xa[mt][0]); xa[mt][1] = mfma16(f.aw[mt][ks], b1, xa[mt][1]); }
    }
    const size_t cbase = (size_t)(h * 128 + n) * CH;
#pragma unroll
    for (int mt = 0; mt < 2; ++mt)
#pragma unroll
        for (int nt = 0; nt < 2; ++nt) {
            const uint2 uu = f.u[mt][nt];
            const uint2 p = pack4(__uint_as_float(uu.x << 16) - xa[mt][nt][0], __uint_as_float(uu.x & 0xffff0000u) - xa[mt][nt][1],
                                  __uint_as_float(uu.y << 16) - xa[mt][nt][2], __uint_as_float(uu.y & 0xffff0000u) - xa[mt][nt][3]);
            *(uint2*)&VT[16 * nt + r][32 * w + 16 * mt + quad * 4] = p;
            *(uint2*)(VnT + cbase + (size_t)(32 * c + 16 * nt + r) * 128 + 32 * w + 16 * mt + quad * 4) = p;
        }
    __syncthreads();
#pragma unroll
    for (int mt = 0; mt < 2; ++mt)
#pragma unroll
        for (int nt = 0; nt < 2; ++nt) s[mt][nt] *= f.dec;
#pragma unroll
    for (int ks = 0; ks < 4; ++ks) {
        const bf16x8 b0 = *(const bf16x8*)&VT[r][ks * 32 + quad * 8], b1 = *(const bf16x8*)&VT[16 + r][ks * 32 + quad * 8];
#pragma unroll
        for (int mt = 0; mt < 2; ++mt) { s[mt][0] = mfma16(f.ak[mt][ks], b0, s[mt][0]); s[mt][1] = mfma16(f.ak[mt][ks], b1, s[mt][1]); }
    }
#pragma unroll
    for (int mt = 0; mt < 2; ++mt)
#pragma unroll
        for (int nt = 0; nt < 2; ++nt) {
            const uint2 p = pack4(s[mt][nt][0], s[mt][nt][1], s[mt][nt][2], s[mt][nt][3]);
            *(uint2*)&ST[16 * nt + r][32 * w + 16 * mt + quad * 4] = p;
            if (n + 1 < 128) *(uint2*)(Sst + cbase + CH + (size_t)(32 * c + 16 * nt + r) * 128 + 32 * w + 16 * mt + quad * 4) = p;
        }
    __syncthreads();
}
__device__ __forceinline__ void gdn_scan(int b, unsigned char* smem, const bf16_t* __restrict__ UT, const bf16_t* __restrict__ Wm, const bf16_t* __restrict__ KstT,
                                         const float* __restrict__ gcb, bf16_t* __restrict__ VnT, bf16_t* __restrict__ Sst) {
    const int h = b >> 2, c = b & 3;
    const int tid = threadIdx.x, lane = tid & 63, w = tid >> 6, r = lane & 15, quad = lane >> 4;
    bf16_t (*ST)[LDT] = (bf16_t(*)[LDT])smem;
    bf16_t (*VT)[LDT] = (bf16_t(*)[LDT])(smem + 32 * LDT * 2);
    for (int u = tid; u < 32 * LDT / 2; u += 256) ((unsigned*)smem)[u] = 0u;
    {
        const size_t cb0 = (size_t)(h * 128) * CH;
        for (int u = tid; u < 32 * 16; u += 256) *(uint4*)(Sst + cb0 + (size_t)(32 * c + (u >> 4)) * 128 + (u & 15) * 8) = make_uint4(0u, 0u, 0u, 0u);
    }
    f32x4 s[2][2];
#pragma unroll
    for (int mt = 0; mt < 2; ++mt)
#pragma unroll
        for (int nt = 0; nt < 2; ++nt) s[mt][nt] = (f32x4){0.f, 0.f, 0.f, 0.f};
    __syncthreads();
    ScanFrags f0, f1;
    scan_load(f0, h, 0, c, w, r, quad, UT, Wm, KstT, gcb);
    for (int n = 0; n < 128; n += 2) {
        scan_load(f1, h, n + 1, c, w, r, quad, UT, Wm, KstT, gcb);
        scan_step(f0, s, h, n, c, w, r, quad, ST, VT, VnT, Sst);
        scan_load(f0, h, (n + 2 < 128) ? n + 2 : 127, c, w, r, quad, UT, Wm, KstT, gcb);
        scan_step(f1, s, h, n + 1, c, w, r, quad, ST, VT, VnT, Sst);
    }
}

__device__ __forceinline__ void gdn_phaseC(int item, unsigned char* smem, const bf16_t* __restrict__ projb, const float* __restrict__ conv_w, const bf16_t* __restrict__ kn,
                                           const float* __restrict__ gcb, const bf16_t* __restrict__ VnT, const bf16_t* __restrict__ Sst,
                                           const float* __restrict__ gdn_norm_w, bf16_t* __restrict__ mixed) {
    const int h = item & 3, n = item >> 2, t0 = n * 128;
    const int tid = threadIdx.x, lane = tid & 63, w = tid >> 6;
    const int wr = w >> 1, wc = w & 1, r = lane & 15, quad = lane >> 4;
    { int zoff = 0; asm volatile("" : "+s"(zoff)); smem += zoff; }
    float* gcs = (float*)smem;
    float* cw = gcs + 128;
    float* red = cw + 512;
    bf16_t (*Qt)[LDT] = (bf16_t(*)[LDT])(smem + 3584);
    bf16_t (*Kt)[LDT] = (bf16_t(*)[LDT])(smem + 3584 + 128 * LDT * 2);
    const size_t cbase = (size_t)(h * 128 + n) * CH;
    if (tid < 128) gcs[tid] = gcb[(size_t)(h * 128 + n) * 128 + tid];
    for (int u = tid; u < 512; u += 256) cw[u] = conv_w[(u >> 7) * 1536 + h * 128 + (u & 127)];
#pragma unroll
    for (int j = 0; j < 8; ++j) {
        const int c = tid + 256 * j, row = c >> 4, cc = c & 15;
        *(uint4*)&Kt[row][cc * 8] = *(const uint4*)(kn + (size_t)(t0 + row) * 512 + h * 128 + cc * 8);
    }
    __syncthreads();
    conv_norm_rows(projb, t0, C_GQ + h * 128, cw, Qt, nullptr);
    __syncthreads();
    f32x4 acc[4][4];
#pragma unroll
    for (int i = 0; i < 4; ++i)
#pragma unroll
        for (int j = 0; j < 4; ++j) acc[i][j] = (f32x4){0.f, 0.f, 0.f, 0.f};
    if (!(wr == 0 && wc == 1)) {
#pragma unroll
        for (int ks = 0; ks < 4; ++ks) {
            bf16x8 a[4], b[4];
#pragma unroll
            for (int i = 0; i < 4; ++i) a[i] = *(const bf16x8*)&Qt[wr * 64 + i * 16 + r][ks * 32 + quad * 8];
#pragma unroll
            for (int j = 0; j < 4; ++j) b[j] = *(const bf16x8*)&Kt[wc * 64 + j * 16 + r][ks * 32 + quad * 8];
#pragma unroll
            for (int i = 0; i < 4; ++i)
#pragma unroll
                for (int j = 0; j < 4; ++j) acc[i][j] = mfma16(b[j], a[i], acc[i][j]);
        }
    }
    __syncthreads();
#pragma unroll
    for (int i = 0; i < 4; ++i) {
        const int row = wr * 64 + i * 16 + r;
        const float gi = gcs[row];
#pragma unroll
        for (int j = 0; j < 4; ++j) {
            const int c0 = wc * 64 + j * 16 + quad * 4;
            float o[4];
#pragma unroll
            for (int v = 0; v < 4; ++v) o[v] = (c0 + v <= row) ? acc[i][j][v] * QSCALE * __expf(gi - gcs[c0 + v]) : 0.f;
            *(uint2*)&Kt[row][c0] = pack4(o[0], o[1], o[2], o[3]);
        }
    }
    __syncthreads();
#pragma unroll
    for (int i = 0; i < 4; ++i)
#pragma unroll
        for (int j = 0; j < 4; ++j) acc[i][j] = (f32x4){0.f, 0.f, 0.f, 0.f};
#pragma unroll
    for (int ks = 0; ks < 4; ++ks) {
        bf16x8 a[4], b[4];
#pragma unroll
        for (int i = 0; i < 4; ++i) a[i] = *(const bf16x8*)&Qt[wr * 64 + i * 16 + r][ks * 32 + quad * 8];
#pragma unroll
        for (int j = 0; j < 4; ++j) b[j] = *(const bf16x8*)(Sst + cbase + (size_t)(wc * 64 + j * 16 + r) * 128 + ks * 32 + quad * 8);
#pragma unroll
        for (int i = 0; i < 4; ++i)
#pragma unroll
            for (int j = 0; j < 4; ++j) acc[i][j] = mfma16(b[j], a[i], acc[i][j]);
    }
#pragma unroll
    for (int i = 0; i < 4; ++i) {
        const float sc = QSCALE * __expf(gcs[wr * 64 + i * 16 + r]);
#pragma unroll
        for (int j = 0; j < 4; ++j) acc[i][j] *= sc;
    }
#pragma unroll
    for (int ks = 0; ks < 4; ++ks) {
        bf16x8 a[4], b[4];
#pragma unroll
        for (int i = 0; i < 4; ++i) a[i] = *(const bf16x8*)&Kt[wr * 64 + i * 16 + r][ks * 32 + quad * 8];
#pragma unroll
        for (int j = 0; j < 4; ++j) b[j] = *(const bf16x8*)(VnT + cbase + (size_t)(wc * 64 + j * 16 + r) * 128 + ks * 32 + quad * 8);
#pragma unroll
        for (int i = 0; i < 4; ++i)
#pragma unroll
            for (int j = 0; j < 4; ++j) acc[i][j] = mfma16(b[j], a[i], acc[i][j]);
    }
#pragma unroll
    for (int i = 0; i < 4; ++i) {
        float ss = 0.f;
#pragma unroll
        for (int j = 0; j < 4; ++j)
#pragma unroll
            for (int v = 0; v < 4; ++v) ss += acc[i][j][v] * acc[i][j][v];
        ss += __shfl_xor(ss, 16); ss += __shfl_xor(ss, 32);
        if (quad == 0) red[wc * 128 + wr * 64 + i * 16 + r] = ss;
    }
    __syncthreads();
#pragma unroll
    for (int i = 0; i < 4; ++i) {
        const int row = wr * 64 + i * 16 + r;
        const float rs = rsqrtf((red[row] + red[128 + row]) * (1.f / 128.f) + EPS);
#pragma unroll
        for (int j = 0; j < 4; ++j) {
            const int e0 = wc * 64 + j * 16 + quad * 4;
            const uint2 gz = *(const uint2*)(projb + (size_t)(t0 + row) * NPROJ + C_GZ + h * 128 + e0);
            const float4 nw = *(const float4*)(gdn_norm_w + e0);
            const uint2 p = pack4(acc[i][j][0] * rs * nw.x * silu(__uint_as_float(gz.x << 16)), acc[i][j][1] * rs * nw.y * silu(__uint_as_float(gz.x & 0xffff0000u)),
                                  acc[i][j][2] * rs * nw.z * silu(__uint_as_float(gz.y << 16)), acc[i][j][3] * rs * nw.w * silu(__uint_as_float(gz.y & 0xffff0000u)));
            *(uint2*)(mixed + (size_t)(t0 + row) * 1024 + 512 + h * 128 + e0) = p;
        }
    }
    __syncthreads();
}


__device__ __forceinline__ void ret_phaseA(int item, unsigned char* smem, const bf16_t* __restrict__ projb,
                                           bf16_t* __restrict__ rqr, bf16_t* __restrict__ rkr, bf16_t* __restrict__ VTg, float* __restrict__ kvT) {
    const int h = item & 3, n = item >> 2, t0 = n * 128;
    const int tid = threadIdx.x, lane = tid & 63, w = tid >> 6, r = lane & 15, quad = lane >> 4;
    { int zoff = 0; asm volatile("" : "+s"(zoff)); smem += zoff; }
    bf16_t (*VT)[LDT] = (bf16_t(*)[LDT])smem;
    bf16_t (*KT)[LDT] = (bf16_t(*)[LDT])(smem + 128 * LDT * 2);
    const float lg2 = log2f(1.f - exp2f(-5.f - (float)h));
    {
        const int i = tid >> 1, hf = tid & 1, t = t0 + i;
        const bf16_t* pq = projb + (size_t)t * NPROJ + C_RQ + h * 64 + hf * 16;
        const bf16_t* pk = projb + (size_t)t * NPROJ + C_RK + h * 64 + hf * 16;
        uint4 ql[2], qh[2], kl[2], kh[2];
        ql[0] = *(const uint4*)pq; ql[1] = *(const uint4*)(pq + 8); qh[0] = *(const uint4*)(pq + 32); qh[1] = *(const uint4*)(pq + 40);
        kl[0] = *(const uint4*)pk; kl[1] = *(const uint4*)(pk + 8); kh[0] = *(const uint4*)(pk + 32); kh[1] = *(const uint4*)(pk + 40);
        const unsigned* qlw = (const unsigned*)ql; const unsigned* qhw = (const unsigned*)qh; const unsigned* klw = (const unsigned*)kl; const unsigned* khw = (const unsigned*)kh;
        const float kdec = exp2f((float)(127 - i) * lg2);
        unsigned oql[8], oqh[8], okl[8], okh[8];
#pragma unroll
        for (int p = 0; p < 8; ++p) {
            float q1[2], q2[2], k1[2], k2[2];
#pragma unroll
            for (int s = 0; s < 2; ++s) {
                const int j = hf * 16 + 2 * p + s;
                double u = (double)t * INVREV[j];
                u -= rint(u);
                const float fr = (float)u;
                const float sn = __builtin_amdgcn_sinf(fr), cs = __builtin_amdgcn_cosf(fr);
                const float qa = s ? __uint_as_float(qlw[p] & 0xffff0000u) : __uint_as_float(qlw[p] << 16);
                const float qb = s ? __uint_as_float(qhw[p] & 0xffff0000u) : __uint_as_float(qhw[p] << 16);
                const float ka = s ? __uint_as_float(klw[p] & 0xffff0000u) : __uint_as_float(klw[p] << 16);
                const float kb = s ? __uint_as_float(khw[p] & 0xffff0000u) : __uint_as_float(khw[p] << 16);
                q1[s] = qa * cs - qb * sn; q2[s] = qa * sn + qb * cs;
                k1[s] = (ka * cs - kb * sn) * 0.125f; k2[s] = (ka * sn + kb * cs) * 0.125f;
                KT[j][i] = f2bf(k1[s] * kdec);
                KT[j + 32][i] = f2bf(k2[s] * kdec);
            }
            oql[p] = (unsigned)f2bf(q1[0]) | ((unsigned)f2bf(q1[1]) << 16); oqh[p] = (unsigned)f2bf(q2[0]) | ((unsigned)f2bf(q2[1]) << 16);
            okl[p] = (unsigned)f2bf(k1[0]) | ((unsigned)f2bf(k1[1]) << 16); okh[p] = (unsigned)f2bf(k2[0]) | ((unsigned)f2bf(k2[1]) << 16);
        }
        bf16_t* oq = rqr + (size_t)t * 256 + h * 64 + hf * 16;
        bf16_t* ok = rkr + (size_t)t * 256 + h * 64 + hf * 16;
        *(uint4*)oq = make_uint4(oql[0], oql[1], oql[2], oql[3]); *(uint4*)(oq + 8) = make_uint4(oql[4], oql[5], oql[6], oql[7]);
        *(uint4*)(oq + 32) = make_uint4(oqh[0], oqh[1], oqh[2], oqh[3]); *(uint4*)(oq + 40) = make_uint4(oqh[4], oqh[5], oqh[6], oqh[7]);
        *(uint4*)ok = make_uint4(okl[0], okl[1], okl[2], okl[3]); *(uint4*)(ok + 8) = make_uint4(okl[4], okl[5], okl[6], okl[7]);
        *(uint4*)(ok + 32) = make_uint4(okh[0], okh[1], okh[2], okh[3]); *(uint4*)(ok + 40) = make_uint4(okh[4], okh[5], okh[6], okh[7]);
        const bf16_t* pv = projb + (size_t)t * NPROJ + C_RV + h * 128 + hf * 64;
#pragma unroll
        for (int g = 0; g < 8; ++g) {
            const uint4 raw = *(const uint4*)(pv + g * 8);
            const int e = hf * 64 + g * 8;
            VT[e + 0][i] = (bf16_t)(raw.x & 0xffffu); VT[e + 1][i] = (bf16_t)(raw.x >> 16);
            VT[e + 2][i] = (bf16_t)(raw.y & 0xffffu); VT[e + 3][i] = (bf16_t)(raw.y >> 16);
            VT[e + 4][i] = (bf16_t)(raw.z & 0xffffu); VT[e + 5][i] = (bf16_t)(raw.z >> 16);
            VT[e + 6][i] = (bf16_t)(raw.w & 0xffffu); VT[e + 7][i] = (bf16_t)(raw.w >> 16);
        }
    }
    __syncthreads();
    const size_t cbase = (size_t)(h * 128 + n) * CH;
#pragma unroll
    for (int j = 0; j < 8; ++j) {
        const int c = tid + 256 * j, row = c >> 4, cc = c & 15;
        *(uint4*)(VTg + cbase + (size_t)row * 128 + cc * 8) = *(const uint4*)&VT[row][cc * 8];
    }
    f32x4 acc[2][4];
#pragma unroll
    for (int mt = 0; mt < 2; ++mt)
#pragma unroll
        for (int nt = 0; nt < 4; ++nt) acc[mt][nt] = (f32x4){0.f, 0.f, 0.f, 0.f};
#pragma unroll
    for (int ks = 0; ks < 4; ++ks) {
        bf16x8 a[2], b[4];
#pragma unroll
        for (int mt = 0; mt < 2; ++mt) a[mt] = *(const bf16x8*)&VT[32 * w + 16 * mt + r][ks * 32 + quad * 8];
#pragma unroll
        for (int nt = 0; nt < 4; ++nt) b[nt] = *(const bf16x8*)&KT[16 * nt + r][ks * 32 + quad * 8];
#pragma unroll
        for (int mt = 0; mt < 2; ++mt)
#pragma unroll
            for (int nt = 0; nt < 4; ++nt) acc[mt][nt] = mfma16(b[nt], a[mt], acc[mt][nt]);
    }
    float* kvp = kvT + (size_t)(h * 128 + n) * 8192;
#pragma unroll
    for (int mt = 0; mt < 2; ++mt)
#pragma unroll
        for (int nt = 0; nt < 4; ++nt)
            *(float4*)(kvp + (size_t)(32 * w + 16 * mt + r) * 64 + 16 * nt + quad * 4) = make_float4(acc[mt][nt][0], acc[mt][nt][1], acc[mt][nt][2], acc[mt][nt][3]);
    __syncthreads();
}

__device__ __forceinline__ void ret_scan(int gid, const float* __restrict__ kvT, bf16_t* __restrict__ Srt) {
    const int h = gid >> 13, rem = gid & 8191;
    const float Gam = exp2f(128.f * log2f(1.f - exp2f(-5.f - (float)h)));
    float S = 0.f;
    const float* kp = kvT + (size_t)h * 128 * 8192 + rem;
    bf16_t* sp = Srt + (size_t)h * 128 * 8192 + rem;
    for (int n0 = 0; n0 < 128; n0 += 8) {
        float kv[8];
#pragma unroll
        for (int i = 0; i < 8; ++i) kv[i] = kp[(size_t)(n0 + i) * 8192];
#pragma unroll
        for (int i = 0; i < 8; ++i) { sp[(size_t)(n0 + i) * 8192] = f2bf(S); S = Gam * S + kv[i]; }
    }
}

__device__ __forceinline__ void ret_phaseC(int item, unsigned char* smem, const bf16_t* __restrict__ projb, const bf16_t* __restrict__ rqr, const bf16_t* __restrict__ rkr,
                                           const bf16_t* __restrict__ VTg, const bf16_t* __restrict__ Srt, const float* __restrict__ ret_norm_w, bf16_t* __restrict__ mixed) {
    const int h = item & 3, n = item >> 2, t0 = n * 128;
    const int tid = threadIdx.x, lane = tid & 63, w = tid >> 6;
    const int wr = w >> 1, wc = w & 1, r = lane & 15, quad = lane >> 4;
    { int zoff = 0; asm volatile("" : "+s"(zoff)); smem += zoff; }
    float* red = (float*)smem;
    bf16_t (*Qr)[GLD] = (bf16_t(*)[GLD])(smem + 2048);
    bf16_t (*Kr)[GLD] = (bf16_t(*)[GLD])(smem + 2048 + 128 * GLD * 2);
    bf16_t (*Sc)[LDT] = (bf16_t(*)[LDT])(smem + 2048 + 2 * 128 * GLD * 2);
    const float lg2 = log2f(1.f - exp2f(-5.f - (float)h));
#pragma unroll
    for (int j = 0; j < 4; ++j) {
        const int c = tid + 256 * j, row = c >> 3, cc = c & 7;
        *(uint4*)&Qr[row][cc * 8] = *(const uint4*)(rqr + (size_t)(t0 + row) * 256 + h * 64 + cc * 8);
        *(uint4*)&Kr[row][cc * 8] = *(const uint4*)(rkr + (size_t)(t0 + row) * 256 + h * 64 + cc * 8);
    }
    __syncthreads();
    f32x4 acc[4][4];
#pragma unroll
    for (int i = 0; i < 4; ++i)
#pragma unroll
        for (int j = 0; j < 4; ++j) acc[i][j] = (f32x4){0.f, 0.f, 0.f, 0.f};
    if (!(wr == 0 && wc == 1)) {
#pragma unroll
        for (int ks = 0; ks < 2; ++ks) {
            bf16x8 a[4], b[4];
#pragma unroll
            for (int i = 0; i < 4; ++i) a[i] = *(const bf16x8*)&Qr[wr * 64 + i * 16 + r][ks * 32 + quad * 8];
#pragma unroll
            for (int j = 0; j < 4; ++j) b[j] = *(const bf16x8*)&Kr[wc * 64 + j * 16 + r][ks * 32 + quad * 8];
#pragma unroll
            for (int i = 0; i < 4; ++i)
#pragma unroll
                for (int j = 0; j < 4; ++j) acc[i][j] = mfma16(b[j], a[i], acc[i][j]);
        }
    }
#pragma unroll
    for (int i = 0; i < 4; ++i) {
        const int row = wr * 64 + i * 16 + r;
#pragma unroll
        for (int j = 0; j < 4; ++j) {
            const int c0 = wc * 64 + j * 16 + quad * 4;
            float o[4];
#pragma unroll
            for (int v = 0; v < 4; ++v) o[v] = (c0 + v <= row) ? acc[i][j][v] * exp2f((float)(row - c0 - v) * lg2) : 0.f;
            *(uint2*)&Sc[row][c0] = pack4(o[0], o[1], o[2], o[3]);
        }
    }
    __syncthreads();
    const size_t cbase = (size_t)(h * 128 + n) * CH;
    const bf16_t* sp = Srt + (size_t)(h * 128 + n) * 8192;
#pragma unroll
    for (int i = 0; i < 4; ++i)
#pragma unroll
        for (int j = 0; j < 4; ++j) acc[i][j] = (f32x4){0.f, 0.f, 0.f, 0.f};
#pragma unroll
    for (int ks = 0; ks < 2; ++ks) {
        bf16x8 a[4], b[4];
#pragma unroll
        for (int i = 0; i < 4; ++i) a[i] = *(const bf16x8*)&Qr[wr * 64 + i * 16 + r][ks * 32 + quad * 8];
#pragma unroll
        for (int j = 0; j < 4; ++j) b[j] = *(const bf16x8*)(sp + (size_t)(wc * 64 + j * 16 + r) * 64 + ks * 32 + quad * 8);
#pragma unroll
        for (int i = 0; i < 4; ++i)
#pragma unroll
            for (int j = 0; j < 4; ++j) acc[i][j] = mfma16(b[j], a[i], acc[i][j]);
    }
#pragma unroll
    for (int i = 0; i < 4; ++i) {
        const float sc = exp2f((float)(wr * 64 + i * 16 + r + 1) * lg2);
#pragma unroll
        for (int j = 0; j < 4; ++j) acc[i][j] *= sc;
    }
#pragma unroll
    for (int ks = 0; ks < 4; ++ks) {
        bf16x8 a[4], b[4];
#pragma unroll
        for (int i = 0; i < 4; ++i) a[i] = *(const bf16x8*)&Sc[wr * 64 + i * 16 + r][ks * 32 + quad * 8];
#pragma unroll
        for (int j = 0; j < 4; ++j) b[j] = *(const bf16x8*)(VTg + cbase + (size_t)(wc * 64 + j * 16 + r) * 128 + ks * 32 + quad * 8);
#pragma unroll
        for (int i = 0; i < 4; ++i)
#pragma unroll
            for (int j = 0; j < 4; ++j) acc[i][j] = mfma16(b[j], a[i], acc[i][j]);
    }
#pragma unroll
    for (int i = 0; i < 4; ++i) {
        float s1 = 0.f, s2 = 0.f;
#pragma unroll
        for (int j = 0; j < 4; ++j)
#pragma unroll
            for (int v = 0; v < 4; ++v) { s1 += acc[i][j][v]; s2 += acc[i][j][v] * acc[i][j][v]; }
        s1 += __shfl_xor(s1, 16); s1 += __shfl_xor(s1, 32);
        s2 += __shfl_xor(s2, 16); s2 += __shfl_xor(s2, 32);
        if (quad == 0) { red[wc * 128 + wr * 64 + i * 16 + r] = s1; red[256 + wc * 128 + wr * 64 + i * 16 + r] = s2; }
    }
    __syncthreads();
#pragma unroll
    for (int i = 0; i < 4; ++i) {
        const int row = wr * 64 + i * 16 + r;
        const float mu = (red[row] + red[128 + row]) * (1.f / 128.f);
        const float var = fmaxf((red[256 + row] + red[384 + row]) * (1.f / 128.f) - mu * mu, 0.f);
        const float rs = rsqrtf(var + EPS);
#pragma unroll
        for (int j = 0; j < 4; ++j) {
            const int e0 = wc * 64 + j * 16 + quad * 4;
            const uint2 gz = *(const uint2*)(projb + (size_t)(t0 + row) * NPROJ + C_RG + h * 128 + e0);
            const float4 nw = *(const float4*)(ret_norm_w + h * 128 + e0);
            const uint2 p = pack4((acc[i][j][0] - mu) * rs * nw.x * silu(__uint_as_float(gz.x << 16)), (acc[i][j][1] - mu) * rs * nw.y * silu(__uint_as_float(gz.x & 0xffff0000u)),
                                  (acc[i][j][2] - mu) * rs * nw.z * silu(__uint_as_float(gz.y << 16)), (acc[i][j][3] - mu) * rs * nw.w * silu(__uint_as_float(gz.y & 0xffff0000u)));
            *(uint2*)(mixed + (size_t)(t0 + row) * 1024 + h * 128 + e0) = p;
        }
    }
    __syncthreads();
}


__device__ __forceinline__ void k_rope(int bid, const bf16_t* __restrict__ projb, bf16_t* __restrict__ rqr, bf16_t* __restrict__ rkr) {
    const int t = bid, tid = threadIdx.x;
    const int which = tid >> 7, h = (tid >> 5) & 3, j = tid & 31;
    const bf16_t* p = projb + (size_t)t * NPROJ + which * 256 + h * 64;
    const float a = bf2f(p[j]), b = bf2f(p[j + 32]);
    double u = (double)t * INVREV[j];
    u -= rint(u);
    const float fr = (float)u;
    const float sn = __builtin_amdgcn_sinf(fr), cs = __builtin_amdgcn_cosf(fr);
    const float sc = which ? 0.125f : 1.f;
    bf16_t* o = (which ? rkr : rqr) + (size_t)t * 256 + h * 64;
    o[j] = f2bf((a * cs - b * sn) * sc);
    o[j + 32] = f2bf((a * sn + b * cs) * sc);
}
__device__ __forceinline__ void k_mixnorm_ret(int bid, const float* __restrict__ o_r, const bf16_t* __restrict__ projb, const float* __restrict__ ret_norm_w, bf16_t* __restrict__ mixed) {
    const int gw = bid * 4 + (threadIdx.x >> 6), l = threadIdx.x & 63;
    const int t = gw >> 2, g = gw & 3;
    const float2 o = *(const float2*)(o_r + (size_t)t * 512 + g * 128 + 2 * l);
    const float mu = wave_sum(o.x + o.y) * (1.f / 128.f);
    const float d0 = o.x - mu, d1 = o.y - mu;
    const float var = wave_sum(d0 * d0 + d1 * d1) * (1.f / 128.f);
    const float rs = rsqrtf(var + EPS);
    const bf16_t* gp = projb + (size_t)t * NPROJ + C_RG + g * 128 + 2 * l;
    const float y0 = d0 * rs * ret_norm_w[g * 128 + 2 * l] * silu(bf2f(gp[0]));
    const float y1 = d1 * rs * ret_norm_w[g * 128 + 2 * l + 1] * silu(bf2f(gp[1]));
    bf16_t* mp = mixed + (size_t)t * 1024 + g * 128 + 2 * l;
    mp[0] = f2bf(y0); mp[1] = f2bf(y1);
}

struct Params {
    const float* in[15];
    float* out;
    unsigned char* ws;
};
constexpr size_t MiB = 1024 * 1024;
constexpr size_t OFF_WIN = 0;
constexpr size_t OFF_WOUT = OFF_WIN + (size_t)NPROJ * 1024 * 2;
constexpr size_t OFF_WQ = OFF_WOUT + (size_t)1024 * 1024 * 2;
constexpr size_t OFF_KEYS = OFF_WQ + (size_t)2048 * 1024 * 2;
constexpr size_t OFF_R1 = OFF_KEYS + (size_t)16 * 128 * 128 * 2;
constexpr size_t OFF_R2 = OFF_R1 + 65536;
constexpr size_t OFF_GDEC = OFF_R2 + 65536;
constexpr size_t OFF_BETA = OFF_GDEC + 262144;
constexpr size_t OFF_GCB = OFF_BETA + 262144;
constexpr size_t OFF_C = ((OFF_GCB + 262144 + MiB - 1) / MiB) * MiB;
constexpr size_t OFF_D = OFF_C + 32 * MiB;
constexpr size_t OFF_E = OFF_D + 112 * MiB;
constexpr size_t WS_END = OFF_E + 64 * MiB;
constexpr int SMEM_BYTES = 2 * 2 * 128 * GLD * 2;

#define GRID_LOOP(b, n) for (int b = blockIdx.x; b < (n); b += gridDim.x)

__global__ __launch_bounds__(256) void mega(Params p) {
    cg::grid_group grid = cg::this_grid();
    __shared__ __attribute__((aligned(16))) unsigned char smem[SMEM_BYTES];
    const float* x = p.in[0]; const float* ln1_w = p.in[1]; const float* w_in = p.in[2]; const float* ret_norm_w = p.in[3];
    const float* conv_w = p.in[4]; const float* A_log = p.in[5]; const float* dt_bias = p.in[6]; const float* gdn_norm_w = p.in[7];
    const float* w_out = p.in[8]; const float* ln2_w = p.in[9]; const float* peer_wq = p.in[10]; const float* peer_keys = p.in[11];
    const float* peer_u = p.in[12]; const float* peer_v = p.in[13]; const float* lnf_w = p.in[14];
    float* out = p.out; unsigned char* ws = p.ws;
    bf16_t* WinT = (bf16_t*)(ws + OFF_WIN); bf16_t* WoutT = (bf16_t*)(ws + OFF_WOUT); bf16_t* WqT = (bf16_t*)(ws + OFF_WQ); bf16_t* keysb = (bf16_t*)(ws + OFF_KEYS);
    float* r1 = (float*)(ws + OFF_R1); float* r2 = (float*)(ws + OFF_R2); float* gdec = (float*)(ws + OFF_GDEC); float* beta = (float*)(ws + OFF_BETA);
    bf16_t* xb = (bf16_t*)(ws + OFF_C); bf16_t* x2b = xb;
    bf16_t* projb = (bf16_t*)(ws + OFF_D); bf16_t* qp = projb;
    unsigned* top1 = (unsigned*)(ws + OFF_D + 64 * MiB); int* sel_id = (int*)(ws + OFF_D + 80 * MiB); float* sel_g = (float*)(ws + OFF_D + 88 * MiB);
    bf16_t* UT = (bf16_t*)(ws + OFF_E); bf16_t* mixed = UT; bf16_t* Wm = (bf16_t*)(ws + OFF_E + 16 * MiB); bf16_t* KstT = (bf16_t*)(ws + OFF_E + 32 * MiB);
    bf16_t* kn = (bf16_t*)(ws + OFF_E + 48 * MiB);
    bf16_t* VnT = (bf16_t*)(ws + OFF_C); bf16_t* Sst = (bf16_t*)(ws + OFF_C + 16 * MiB);
    float* gcb = (float*)(ws + OFF_GCB);
    float* kvT = out; bf16_t* Srt = (bf16_t*)((unsigned char*)out + 16 * MiB);
    bf16_t* rqr = (bf16_t*)((unsigned char*)out + 24 * MiB); bf16_t* rkr = (bf16_t*)((unsigned char*)out + 32 * MiB); bf16_t* VTg = (bf16_t*)((unsigned char*)out + 40 * MiB);

    GRID_LOOP(b, T_ / 4) k_prep_x(b, x, ln1_w, w_in, A_log, dt_bias, xb, r1, gdec, beta);
    GRID_LOOP(b, (NPROJ / 32) * 32) k_transpose(b % (NPROJ / 32), b / (NPROJ / 32), (float(*)[33])smem, w_in, LDWIN, ln1_w, WinT, 1024);
    GRID_LOOP(b, 32 * 32) k_transpose(b % 32, b / 32, (float(*)[33])smem, w_out, 1024, nullptr, WoutT, 1024);
    GRID_LOOP(b, 64 * 32) k_transpose(b % 64, b / 64, (float(*)[33])smem, peer_wq, 2048, ln2_w, WqT, 1024);
    GRID_LOOP(b, (16 * 128 * 128 / 4) / 256) k_convert(b, peer_keys, keysb, 16 * 128 * 128 / 4);
    grid.sync();
    GRID_LOOP(b, (T_ / 128) * (NPROJ / 128)) k_gemm<0>(b, smem, xb, 1024, WinT, 1024, 1024, projb, NPROJ, r1, NPROJ / 128);
    grid.sync();
    GRID_LOOP(b, 1024) {
        if (b < 512) gdn_phaseA(b, smem, projb, conv_w, gdec, beta, UT, Wm, KstT, kn, gcb);
        else ret_phaseA(b - 512, smem, projb, rqr, rkr, VTg, kvT);
    }
    grid.sync();
    if (blockIdx.x < 16) gdn_scan(blockIdx.x, smem, UT, Wm, KstT, gcb, VnT, Sst);
    else if (blockIdx.x < 144) ret_scan((blockIdx.x - 16) * 256 + threadIdx.x, kvT, Srt);
    grid.sync();
    GRID_LOOP(b, 1024) {
        if (b < 512) gdn_phaseC(b, smem, projb, conv_w, kn, gcb, VnT, Sst, gdn_norm_w, mixed);
        else ret_phaseC(b - 512, smem, projb, rqr, rkr, VTg, Srt, ret_norm_w, mixed);
    }
    grid.sync();
    GRID_LOOP(b, (T_ / 128) * 8) k_gemm<1>(b, smem, mixed, 1024, WoutT, 1024, 1024, out, 1024, x, 8);
    grid.sync();
    GRID_LOOP(b, T_ / 4) k_rownorm2(b, out, x2b, r2);
    grid.sync();
    GRID_LOOP(b, (T_ / 128) * 16) k_gemm<0>(b, smem, x2b, 1024, WqT, 1024, 1024, qp, 2048, r2, 16);
    grid.sync();
    GRID_LOOP(b, (T_ / 128) * 16) k_scores_topk(b, smem, qp, keysb, top1);
    grid.sync();
    GRID_LOOP(b, T_ * 8 / 256) k_cand(b, top1, sel_id, sel_g);
    grid.sync();
    GRID_LOOP(b, T_ / 4) k_peer(b, out, r2, ln2_w, sel_id, sel_g, peer_u, peer_v, lnf_w, out);
}

extern "C" void kernel_launch(void* const* d_in, const int* in_sizes, int n_in, void* d_out, int out_size, void* d_ws, size_t ws_size, hipStream_t stream) {
    static int grid_blocks = 0;
    if (!grid_blocks) {
        int dev = 0, cus = 0, per_cu = 0;
        hipGetDevice(&dev);
        hipDeviceGetAttribute(&cus, hipDeviceAttributeMultiprocessorCount, dev);
        hipOccupancyMaxActiveBlocksPerMultiprocessor(&per_cu, mega, 256, 0);
        if (per_cu > 2) per_cu = 2;
        if (per_cu < 1) per_cu = 1;
        grid_blocks = cus * per_cu;
    }
    if (n_in < 15 || ws_size < WS_END) { fprintf(stderr, "kernel_launch: unexpected inputs / workspace (%d inputs, %zu bytes)\n", n_in, ws_size); return; }
    Params p{};
    for (int i = 0; i < 15; ++i) p.in[i] = (const float*)d_in[i];
    p.out = (float*)d_out; p.ws = (unsigned char*)d_ws;
    void* args[] = {&p};
    hipError_t e = hipLaunchCooperativeKernel((const void*)mega, dim3(grid_blocks), dim3(256), args, 0, stream);
    if (e != hipSuccess) fprintf(stderr, "cooperative launch failed: %s (grid %d)\n", hipGetErrorString(e), grid_blocks);
}
```

```cpp
#include <hip/hip_runtime.h>
#include <hip/hip_cooperative_groups.h>
#include <stdint.h>
#include <cstdio>
namespace cg = cooperative_groups;

typedef unsigned short bf16_t;
typedef __attribute__((ext_vector_type(8))) short bf16x8;
typedef __attribute__((ext_vector_type(4))) float f32x4;

constexpr int T_ = 16384;
constexpr int NPROJ = 3584;
constexpr int LDWIN = 3592;
constexpr float EPS = 1e-6f;

constexpr int C_RQ = 0, C_RK = 256, C_RV = 512, C_RG = 1024, C_GQ = 1536, C_GK = 2048, C_GV = 2560, C_GZ = 3072;

__constant__ double INVREV[32] = {0.15915494309189535, 0.11934937021124886, 0.08949940160889101, 0.06711508300522726, 0.050329212104487035, 0.03774158471741977, 0.0283021958306234, 0.02122365276477766, 0.015915494309189534, 0.011934937021124886, 0.0089499401608891, 0.006711508300522725, 0.005032921210448704, 0.003774158471741977, 0.00283021958306234, 0.002122365276477766, 0.0015915494309189536, 0.0011934937021124887, 0.0008949940160889102, 0.0006711508300522725, 0.0005032921210448703, 0.0003774158471741977, 0.00028302195830623395, 0.00021223652764777658, 0.00015915494309189535, 0.00011934937021124886, 8.9499401608891e-05, 6.711508300522725e-05, 5.0329212104487035e-05, 3.774158471741978e-05, 2.83021958306234e-05, 2.122365276477766e-05};

__device__ __forceinline__ bf16_t f2bf(float f) {
    unsigned u = __float_as_uint(f);
    u += 0x7fffu + ((u >> 16) & 1u);
    return (bf16_t)(u >> 16);
}
__device__ __forceinline__ float bf2f(bf16_t h) { return __uint_as_float(((unsigned)h) << 16); }
__device__ __forceinline__ float wave_sum(float v) {
#pragma unroll
    for (int o = 32; o > 0; o >>= 1) v += __shfl_xor(v, o);
    return v;
}
__device__ __forceinline__ float silu(float x) { return x / (1.f + __expf(-x)); }
__device__ __forceinline__ unsigned fkey(float f) { unsigned u = __float_as_uint(f); return (u & 0x80000000u) ? ~u : (u | 0x80000000u); }
__device__ __forceinline__ float keyf(unsigned k) { return __uint_as_float((k & 0x80000000u) ? (k & 0x7fffffffu) : ~k); }

__device__ __forceinline__ void k_prep_x(int bid, const float* __restrict__ x, const float* __restrict__ ln1_w, const float* __restrict__ w_in,
                                                const float* __restrict__ A_log, const float* __restrict__ dt_bias,
                                                bf16_t* __restrict__ xb, float* __restrict__ r1, float* __restrict__ gdec, float* __restrict__ beta) {
    const int wave = threadIdx.x >> 6, lane = threadIdx.x & 63;
    const int row = bid * 4 + wave;
    const float* xr = x + (size_t)row * 1024;
    float ss = 0.f;
    float g0 = 0, g1 = 0, g2 = 0, g3 = 0, g4 = 0, g5 = 0, g6 = 0, g7 = 0;
#pragma unroll
    for (int j = 0; j < 4; ++j) {
        const int c = j * 256 + lane * 4;
        const float4 v = *(const float4*)(xr + c);
        const float4 w = *(const float4*)(ln1_w + c);
        ss += v.x * v.x + v.y * v.y + v.z * v.z + v.w * v.w;
        ushort4 o; o.x = f2bf(v.x); o.y = f2bf(v.y); o.z = f2bf(v.z); o.w = f2bf(v.w);
        *(ushort4*)(xb + (size_t)row * 1024 + c) = o;
        const float xs[4] = {v.x * w.x, v.y * w.y, v.z * w.z, v.w * w.w};
#pragma unroll
        for (int e = 0; e < 4; ++e) {
            const float* wp = w_in + (size_t)(c + e) * LDWIN + NPROJ;
            const float4 a = *(const float4*)wp; const float4 b = *(const float4*)(wp + 4);
            g0 += xs[e] * a.x; g1 += xs[e] * a.y; g2 += xs[e] * a.z; g3 += xs[e] * a.w;
            g4 += xs[e] * b.x; g5 += xs[e] * b.y; g6 += xs[e] * b.z; g7 += xs[e] * b.w;
        }
    }
    ss = wave_sum(ss);
    g0 = wave_sum(g0); g1 = wave_sum(g1); g2 = wave_sum(g2); g3 = wave_sum(g3);
    g4 = wave_sum(g4); g5 = wave_sum(g5); g6 = wave_sum(g6); g7 = wave_sum(g7);
    const float r = rsqrtf(ss * (1.f / 1024.f) + EPS);
    if (lane == 0) {
        r1[row] = r;
        const float ga[4] = {g0 * r, g1 * r, g2 * r, g3 * r};
        const float gb[4] = {g4 * r, g5 * r, g6 * r, g7 * r};
#pragma unroll
        for (int h = 0; h < 4; ++h) {
            const float xx = ga[h] + dt_bias[h];
            const float sp = xx > 20.f ? xx : log1pf(expf(xx));
            gdec[row * 4 + h] = -expf(A_log[h]) * sp;
            beta[row * 4 + h] = 1.f / (1.f + expf(-gb[h]));
        }
    }
}

__device__ __forceinline__ void k_transpose(int bidx, int bidy, float (*tile)[33], const float* __restrict__ src, int ld, const float* __restrict__ scale, bf16_t* __restrict__ dst, int K) {
    const int n0 = bidx * 32, k0 = bidy * 32;
    const int tx = threadIdx.x & 31, ty = threadIdx.x >> 5;
#pragma unroll
    for (int j = 0; j < 4; ++j) {
        const int k = k0 + ty + 8 * j;
        const float s = scale ? scale[k] : 1.f;
        tile[ty + 8 * j][tx] = src[(size_t)k * ld + n0 + tx] * s;
    }
    __syncthreads();
#pragma unroll
    for (int j = 0; j < 4; ++j) {
        const int n = n0 + ty + 8 * j;
        dst[(size_t)n * K + k0 + tx] = f2bf(tile[tx][ty + 8 * j]);
    }
    __syncthreads();
}

__device__ __forceinline__ void k_convert(int bid, const float* __restrict__ src, bf16_t* __restrict__ dst, int n4) {
    const int i = bid * 256 + threadIdx.x;
    if (i < n4) {
        const float4 v = ((const float4*)src)[i];
        ushort4 o; o.x = f2bf(v.x); o.y = f2bf(v.y); o.z = f2bf(v.z); o.w = f2bf(v.w);
        ((ushort4*)dst)[i] = o;
    }
}

constexpr int GLD = 72;
template <int EPI>
__device__ __forceinline__ void k_gemm(int bid, unsigned char* smem, const bf16_t* __restrict__ A, int lda, const bf16_t* __restrict__ Bt, int ldb, int K,
                                              void* __restrict__ Cv, int ldc, const float* __restrict__ aux, int ntn) {
    bf16_t (*As)[128][GLD] = (bf16_t(*)[128][GLD])smem;
    bf16_t (*Bs)[128][GLD] = (bf16_t(*)[128][GLD])(smem + 2 * 128 * GLD * 2);
    const int tid = threadIdx.x, lane = tid & 63, w = tid >> 6;
    const int wr = w >> 1, wc = w & 1, r = lane & 15, quad = lane >> 4;
    const int tm = bid / ntn, tn = bid % ntn;
    const int m0 = tm * 128, n0 = tn * 128;
    const bf16_t* Ag = A + (size_t)m0 * lda;
    const bf16_t* Bg = Bt + (size_t)n0 * ldb;
    f32x4 acc[4][4];
#pragma unroll
    for (int i = 0; i < 4; ++i)
#pragma unroll
        for (int j = 0; j < 4; ++j) acc[i][j] = (f32x4){0.f, 0.f, 0.f, 0.f};
    uint4 ra[4], rb[4];
    const int nk = K / 64;
#pragma unroll
    for (int j = 0; j < 4; ++j) {
        const int c = tid + 256 * j, row = c >> 3, cc = c & 7;
        ra[j] = *(const uint4*)(Ag + (size_t)row * lda + cc * 8);
        rb[j] = *(const uint4*)(Bg + (size_t)row * ldb + cc * 8);
    }
#pragma unroll
    for (int j = 0; j < 4; ++j) {
        const int c = tid + 256 * j, row = c >> 3, cc = c & 7;
        *(uint4*)&As[0][row][cc * 8] = ra[j];
        *(uint4*)&Bs[0][row][cc * 8] = rb[j];
    }
    __syncthreads();
    for (int kt = 0; kt < nk; ++kt) {
        const int buf = kt & 1;
        const int kn = (kt + 1 < nk) ? kt + 1 : kt;
#pragma unroll
        for (int j = 0; j < 4; ++j) {
            const int c = tid + 256 * j, row = c >> 3, cc = c & 7;
            ra[j] = *(const uint4*)(Ag + (size_t)row * lda + kn * 64 + cc * 8);
            rb[j] = *(const uint4*)(Bg + (size_t)row * ldb + kn * 64 + cc * 8);
        }
        const bf16_t (*Ab)[GLD] = As[buf];
        const bf16_t (*Bb)[GLD] = Bs[buf];
#pragma unroll
        for (int ks = 0; ks < 2; ++ks) {
            bf16x8 a[4], b[4];
#pragma unroll
            for (int i = 0; i < 4; ++i) a[i] = *(const bf16x8*)&Ab[wr * 64 + i * 16 + r][ks * 32 + quad * 8];
#pragma unroll
            for (int j = 0; j < 4; ++j) b[j] = *(const bf16x8*)&Bb[wc * 64 + j * 16 + r][ks * 32 + quad * 8];
#pragma unroll
            for (int i = 0; i < 4; ++i)
#pragma unroll
                for (int j = 0; j < 4; ++j) acc[i][j] = __builtin_amdgcn_mfma_f32_16x16x32_bf16(b[j], a[i], acc[i][j], 0, 0, 0);
        }
        bf16_t (*An)[GLD] = As[buf ^ 1];
        bf16_t (*Bn)[GLD] = Bs[buf ^ 1];
#pragma unroll
        for (int j = 0; j < 4; ++j) {
            const int c = tid + 256 * j, row = c >> 3, cc = c & 7;
            *(uint4*)&An[row][cc * 8] = ra[j];
            *(uint4*)&Bn[row][cc * 8] = rb[j];
        }
        __syncthreads();
    }
#pragma unroll
    for (int i = 0; i < 4; ++i) {
        const int row = m0 + wr * 64 + i * 16 + r;
        float rs = 1.f;
        if (EPI == 0) rs = aux[row];
#pragma unroll
        for (int j = 0; j < 4; ++j) {
            const int col = n0 + wc * 64 + j * 16 + quad * 4;
            if (EPI == 0) {
                ushort4 o; o.x = f2bf(acc[i][j][0] * rs); o.y = f2bf(acc[i][j][1] * rs); o.z = f2bf(acc[i][j][2] * rs); o.w = f2bf(acc[i][j][3] * rs);
                *(ushort4*)((bf16_t*)Cv + (size_t)row * ldc + col) = o;
            } else {
                const float4 xr = *(const float4*)(aux + (size_t)row * ldc + col);
                float4 o; o.x = xr.x + acc[i][j][0]; o.y = xr.y + acc[i][j][1]; o.z = xr.z + acc[i][j][2]; o.w = xr.w + acc[i][j][3];
                *(float4*)((float*)Cv + (size_t)row * ldc + col) = o;
            }
        }
    }
}

__device__ __forceinline__ void k_preproc(int bid, const bf16_t* __restrict__ projb, const float* __restrict__ conv_w,
                                                 bf16_t* __restrict__ rqr, bf16_t* __restrict__ rkr,
                                                 bf16_t* __restrict__ cq, bf16_t* __restrict__ ck, bf16_t* __restrict__ cv) {
    const int t = bid, tid = threadIdx.x;
    {
        const int which = tid >> 7, h = (tid >> 5) & 3, j = tid & 31;
        const bf16_t* p = projb + (size_t)t * NPROJ + which * 256 + h * 64;
        const float a = bf2f(p[j]), b = bf2f(p[j + 32]);
        double u = (double)t * INVREV[j];
        u -= rint(u);
        const float fr = (float)u;
        const float sn = __builtin_amdgcn_sinf(fr), cs = __builtin_amdgcn_cosf(fr);
        const float sc = which ? 0.125f : 1.f;
        bf16_t* o = (which ? rkr : rqr) + (size_t)t * 256 + h * 64;
        o[j] = f2bf((a * cs - b * sn) * sc);
        o[j + 32] = f2bf((a * sn + b * cs) * sc);
    }
    {
        const int h = tid >> 6, l = tid & 63;
        float vals[3][2];
#pragma unroll
        for (int part = 0; part < 3; ++part)
#pragma unroll
            for (int e = 0; e < 2; ++e) {
                const int c = part * 512 + h * 128 + 2 * l + e;
                float acc = 0.f;
#pragma unroll
                for (int j = 0; j < 4; ++j) {
                    const int tt = t - 3 + j;
                    if (tt >= 0) acc += conv_w[j * 1536 + c] * bf2f(projb[(size_t)tt * NPROJ + C_GQ + c]);
                }
                vals[part][e] = silu(acc);
            }
        const float sq = wave_sum(vals[0][0] * vals[0][0] + vals[0][1] * vals[0][1]);
        const float sk = wave_sum(vals[1][0] * vals[1][0] + vals[1][1] * vals[1][1]);
        const float rq = rsqrtf(sq + EPS), rk = rsqrtf(sk + EPS);
        const size_t o = (size_t)t * 512 + h * 128 + 2 * l;
        cq[o] = f2bf(vals[0][0] * rq); cq[o + 1] = f2bf(vals[0][1] * rq);
        ck[o] = f2bf(vals[1][0] * rk); ck[o + 1] = f2bf(vals[1][1] * rk);
        cv[o] = f2bf(vals[2][0]); cv[o + 1] = f2bf(vals[2][1]);
    }
}

__device__ __forceinline__ void k_recur_ret(int bid, const bf16_t* __restrict__ rqr, const bf16_t* __restrict__ rkr, const bf16_t* __restrict__ projb, float* __restrict__ o_r) {
    const int h = bid >> 7, e = bid & 127, lane = threadIdx.x & 63;
    const float gamma = 1.f - exp2f(-5.f - (float)h);
    float s = 0.f;
    const bf16_t* qp = rqr + h * 64 + lane;
    const bf16_t* kp = rkr + h * 64 + lane;
    const bf16_t* vp = projb + C_RV + h * 128 + e;
    for (int t0 = 0; t0 < T_; t0 += 8) {
        float k[8], q[8], v[8];
#pragma unroll
        for (int i = 0; i < 8; ++i) {
            k[i] = bf2f(kp[(size_t)(t0 + i) * 256]);
            q[i] = bf2f(qp[(size_t)(t0 + i) * 256]);
            v[i] = bf2f(vp[(size_t)(t0 + i) * NPROJ]);
        }
#pragma unroll
        for (int i = 0; i < 8; ++i) {
            s = gamma * s + k[i] * v[i];
            const float p = wave_sum(q[i] * s);
            if (lane == 0) o_r[(size_t)(t0 + i) * 512 + h * 128 + e] = p;
        }
    }
}

__device__ __forceinline__ void k_recur_gdn(int bid, const bf16_t* __restrict__ cq, const bf16_t* __restrict__ ck, const bf16_t* __restrict__ cv,
                                                  const float* __restrict__ gdec, const float* __restrict__ beta, float* __restrict__ o_g) {
    const int h = bid >> 7, e = bid & 127, lane = threadIdx.x & 63;
    float s0 = 0.f, s1 = 0.f;
    const bf16_t* qp = cq + h * 128 + 2 * lane;
    const bf16_t* kp = ck + h * 128 + 2 * lane;
    const bf16_t* vp = cv + h * 128 + e;
    for (int t0 = 0; t0 < T_; t0 += 8) {
        float k0[8], k1[8], q0[8], q1[8], v[8], a[8], b[8];
#pragma unroll
        for (int i = 0; i < 8; ++i) {
            const size_t t = t0 + i;
            k0[i] = bf2f(kp[t * 512]); k1[i] = bf2f(kp[t * 512 + 1]);
            q0[i] = bf2f(qp[t * 512]); q1[i] = bf2f(qp[t * 512 + 1]);
            v[i] = bf2f(vp[t * 512]);
            a[i] = __expf(gdec[t * 4 + h]);
            b[i] = beta[t * 4 + h];
        }
#pragma unroll
        for (int i = 0; i < 8; ++i) {
            const float ks = wave_sum(k0[i] * s0 + k1[i] * s1);
            const float coef = b[i] * (v[i] - a[i] * ks);
            s0 = a[i] * s0 + coef * k0[i];
            s1 = a[i] * s1 + coef * k1[i];
            const float o = wave_sum(q0[i] * s0 + q1[i] * s1) * 0.08838834764831845f;
            if (lane == 0) o_g[(size_t)(t0 + i) * 512 + h * 128 + e] = o;
        }
    }
}

__device__ __forceinline__ void k_mixnorm(int bid, const float* __restrict__ o_r, const float* __restrict__ o_g, const bf16_t* __restrict__ projb,
                                                 const float* __restrict__ ret_norm_w, const float* __restrict__ gdn_norm_w, bf16_t* __restrict__ mixed) {
    const int gw = bid * 4 + (threadIdx.x >> 6), l = threadIdx.x & 63;
    const int t = gw >> 3, g = gw & 7;
    if (g < 4) {
        const float2 o = *(const float2*)(o_r + (size_t)t * 512 + g * 128 + 2 * l);
        const float mu = wave_sum(o.x + o.y) * (1.f / 128.f);
        const float d0 = o.x - mu, d1 = o.y - mu;
        const float var = wave_sum(d0 * d0 + d1 * d1) * (1.f / 128.f);
        const float rs = rsqrtf(var + EPS);
        const bf16_t* gp = projb + (size_t)t * NPROJ + C_RG + g * 128 + 2 * l;
        const float y0 = d0 * rs * ret_norm_w[g * 128 + 2 * l] * silu(bf2f(gp[0]));
        const float y1 = d1 * rs * ret_norm_w[g * 128 + 2 * l + 1] * silu(bf2f(gp[1]));
        bf16_t* mp = mixed + (size_t)t * 1024 + g * 128 + 2 * l;
        mp[0] = f2bf(y0); mp[1] = f2bf(y1);
    } else {
        const int h = g - 4;
        const float2 o = *(const float2*)(o_g + (size_t)t * 512 + h * 128 + 2 * l);
        const float ms = wave_sum(o.x * o.x + o.y * o.y) * (1.f / 128.f);
        const float rs = rsqrtf(ms + EPS);
        const bf16_t* gp = projb + (size_t)t * NPROJ + C_GZ + h * 128 + 2 * l;
        const float y0 = o.x * rs * gdn_norm_w[2 * l] * silu(bf2f(gp[0]));
        const float y1 = o.y * rs * gdn_norm_w[2 * l + 1] * silu(bf2f(gp[1]));
        bf16_t* mp = mixed + (size_t)t * 1024 + 512 + h * 128 + 2 * l;
        mp[0] = f2bf(y0); mp[1] = f2bf(y1);
    }
}

__device__ __forceinline__ void k_rownorm2(int bid, const float* __restrict__ x2, bf16_t* __restrict__ x2b, float* __restrict__ r2) {
    const int row = bid * 4 + (threadIdx.x >> 6), lane = threadIdx.x & 63;
    float ss = 0.f;
#pragma unroll
    for (int j = 0; j < 4; ++j) {
        const int c = j * 256 + lane * 4;
        const float4 v = *(const float4*)(x2 + (size_t)row * 1024 + c);
        ss += v.x * v.x + v.y * v.y + v.z * v.z + v.w * v.w;
        ushort4 o; o.x = f2bf(v.x); o.y = f2bf(v.y); o.z = f2bf(v.z); o.w = f2bf(v.w);
        *(ushort4*)(x2b + (size_t)row * 1024 + c) = o;
    }
    ss = wave_sum(ss);
    if (lane == 0) r2[row] = rsqrtf(ss * (1.f / 1024.f) + EPS);
}

constexpr int SLD = 136;
__device__ __forceinline__ void k_scores_topk(int bid, unsigned char* smem, const bf16_t* __restrict__ qp, const bf16_t* __restrict__ keysb, unsigned* __restrict__ top1) {
    bf16_t (*As)[SLD] = (bf16_t(*)[SLD])smem;
    bf16_t (*Bs)[SLD] = (bf16_t(*)[SLD])(smem + 128 * SLD * 2);
    unsigned (*S)[129] = (unsigned(*)[129])smem;
    const int tid = threadIdx.x, lane = tid & 63, w = tid >> 6;
    const int wr = w >> 1, wc = w & 1, r = lane & 15, quad = lane >> 4;
    const int hp = bid & 15, t0 = (bid >> 4) * 128;
#pragma unroll
    for (int j = 0; j < 8; ++j) {
        const int c = tid + 256 * j, row = c >> 4, cc = c & 15;
        *(uint4*)&As[row][cc * 8] = *(const uint4*)(qp + (size_t)(t0 + row) * 2048 + hp * 128 + cc * 8);
        *(uint4*)&Bs[row][cc * 8] = *(const uint4*)(keysb + (size_t)hp * 16384 + row * 128 + cc * 8);
    }
    __syncthreads();
    f32x4 acc[4][4];
#pragma unroll
    for (int i = 0; i < 4; ++i)
#pragma unroll
        for (int j = 0; j < 4; ++j) acc[i][j] = (f32x4){0.f, 0.f, 0.f, 0.f};
#pragma unroll
    for (int ks = 0; ks < 4; ++ks) {
        bf16x8 a[4], b[4];
#pragma unroll
        for (int i = 0; i < 4; ++i) a[i] = *(const bf16x8*)&As[wr * 64 + i * 16 + r][ks * 32 + quad * 8];
#pragma unroll
        for (int j = 0; j < 4; ++j) b[j] = *(const bf16x8*)&Bs[wc * 64 + j * 16 + r][ks * 32 + quad * 8];
#pragma unroll
        for (int i = 0; i < 4; ++i)
#pragma unroll
            for (int j = 0; j < 4; ++j) acc[i][j] = __builtin_amdgcn_mfma_f32_16x16x32_bf16(b[j], a[i], acc[i][j], 0, 0, 0);
    }
    __syncthreads();
#pragma unroll
    for (int i = 0; i < 4; ++i)
#pragma unroll
        for (int j = 0; j < 4; ++j)
#pragma unroll
            for (int v = 0; v < 4; ++v) {
                const int row = wr * 64 + i * 16 + r, col = wc * 64 + j * 16 + quad * 4 + v;
                S[row][col] = (fkey(acc[i][j][v]) & ~0x7Fu) | (unsigned)col;
            }
    __syncthreads();
    if (tid < 128) {
        unsigned top[16];
#pragma unroll
        for (int i = 0; i < 16; ++i) top[i] = 0u;
        for (int c = 0; c < 128; ++c) {
            const unsigned v = S[tid][c];
            if (v > top[15]) {
                top[15] = v;
#pragma unroll
                for (int i = 15; i > 0; --i) {
                    const unsigned hi = max(top[i - 1], top[i]), lo = min(top[i - 1], top[i]);
                    top[i - 1] = hi; top[i] = lo;
                }
            }
        }
        unsigned* o = top1 + ((size_t)(t0 + tid) * 16 + hp) * 16;
#pragma unroll
        for (int i = 0; i < 4; ++i) *(uint4*)(o + 4 * i) = make_uint4(top[4 * i], top[4 * i + 1], top[4 * i + 2], top[4 * i + 3]);
    }
    __syncthreads();
}

__device__ __forceinline__ void k_cand(int bid, const unsigned* __restrict__ top1, int* __restrict__ sel_id, float* __restrict__ sel_g) {
    const int gid = bid * 256 + threadIdx.x;
    const int t = gid >> 3, h = gid & 7;
    const unsigned* p0 = top1 + ((size_t)t * 16 + h * 2) * 16;
    const unsigned* p1 = p0 + 16;
    float s1[16], s2[16];
#pragma unroll
    for (int i = 0; i < 4; ++i) {
        const uint4 a = *(const uint4*)(p0 + 4 * i), b = *(const uint4*)(p1 + 4 * i);
        s1[4 * i] = keyf(a.x & ~0x7Fu); s1[4 * i + 1] = keyf(a.y & ~0x7Fu); s1[4 * i + 2] = keyf(a.z & ~0x7Fu); s1[4 * i + 3] = keyf(a.w & ~0x7Fu);
        s2[4 * i] = keyf(b.x & ~0x7Fu); s2[4 * i + 1] = keyf(b.y & ~0x7Fu); s2[4 * i + 2] = keyf(b.z & ~0x7Fu); s2[4 * i + 3] = keyf(b.w & ~0x7Fu);
    }
    unsigned top[16];
#pragma unroll
    for (int i = 0; i < 16; ++i) top[i] = 0u;
#pragma unroll
    for (int a = 0; a < 16; ++a)
#pragma unroll
        for (int b = 0; b < 16; ++b)
            if ((a + 1) * (b + 1) <= 16) {
                const unsigned v = (fkey(s1[a] + s2[b]) & ~0xFFu) | (unsigned)(a * 16 + b);
                if (v > top[15]) {
                    top[15] = v;
#pragma unroll
                    for (int i = 15; i > 0; --i) {
                        const unsigned hi = max(top[i - 1], top[i]), lo = min(top[i - 1], top[i]);
                        top[i - 1] = hi; top[i] = lo;
                    }
                }
            }
    float ex[16], sum = 0.f;
    const float m = keyf(top[0] & ~0xFFu);
#pragma unroll
    for (int i = 0; i < 16; ++i) { ex[i] = __expf(keyf(top[i] & ~0xFFu) - m); sum += ex[i]; }
    const float inv = 1.f / sum;
#pragma unroll
    for (int i = 0; i < 16; ++i) {
        const int ab = top[i] & 0xFF;
        const int i1 = p0[ab >> 4] & 0x7F, i2 = p1[ab & 15] & 0x7F;
        sel_id[(size_t)t * 128 + h * 16 + i] = i1 * 128 + i2;
        sel_g[(size_t)t * 128 + h * 16 + i] = ex[i] * inv;
    }
}

__device__ __forceinline__ void k_peer(int bid, const float* x2, const float* __restrict__ r2, const float* __restrict__ ln2_w,
                                              const int* __restrict__ sel_id, const float* __restrict__ sel_g,
                                              const float* __restrict__ peer_u, const float* __restrict__ peer_v, const float* __restrict__ lnf_w,
                                              float* out) {
    const int t = bid * 4 + (threadIdx.x >> 6), lane = threadIdx.x & 63;
    float4 xv[4], h2[4], acc[4];
    const float rr = r2[t];
#pragma unroll
    for (int j = 0; j < 4; ++j) {
        const int c = j * 256 + lane * 4;
        xv[j] = *(const float4*)(x2 + (size_t)t * 1024 + c);
        const float4 w = *(const float4*)(ln2_w + c);
        h2[j] = make_float4(xv[j].x * rr * w.x, xv[j].y * rr * w.y, xv[j].z * rr * w.z, xv[j].w * rr * w.w);
        acc[j] = make_float4(0.f, 0.f, 0.f, 0.f);
    }
    const int id0 = sel_id[(size_t)t * 128 + lane], id1 = sel_id[(size_t)t * 128 + 64 + lane];
    const float gg0 = sel_g[(size_t)t * 128 + lane], gg1 = sel_g[(size_t)t * 128 + 64 + lane];
    for (int half = 0; half < 2; ++half) {
        const int idv = half ? id1 : id0;
        const float gv = half ? gg1 : gg0;
#pragma unroll 4
        for (int k = 0; k < 64; ++k) {
            const int id = __builtin_amdgcn_readlane(idv, k);
            const float gate = __uint_as_float(__builtin_amdgcn_readlane(__float_as_uint(gv), k));
            const float* ur = peer_u + (size_t)id * 1024 + lane * 4;
            float d = 0.f;
#pragma unroll
            for (int j = 0; j < 4; ++j) {
                const float4 u4 = *(const float4*)(ur + 256 * j);
                d += u4.x * h2[j].x + u4.y * h2[j].y + u4.z * h2[j].z + u4.w * h2[j].w;
            }
            d = wave_sum(d);
            const float c = gate * 0.5f * d * (1.f + erff(d * 0.70710678118654752f));
            const float* vr = peer_v + (size_t)id * 1024 + lane * 4;
#pragma unroll
            for (int j = 0; j < 4; ++j) {
                const float4 v4 = *(const float4*)(vr + 256 * j);
                acc[j].x += c * v4.x; acc[j].y += c * v4.y; acc[j].z += c * v4.z; acc[j].w += c * v4.w;
            }
        }
    }
    float ss = 0.f;
#pragma unroll
    for (int j = 0; j < 4; ++j) {
        acc[j].x += xv[j].x; acc[j].y += xv[j].y; acc[j].z += xv[j].z; acc[j].w += xv[j].w;
        ss += acc[j].x * acc[j].x + acc[j].y * acc[j].y + acc[j].z * acc[j].z + acc[j].w * acc[j].w;
    }
    ss = wave_sum(ss);
    const float rs = rsqrtf(ss * (1.f / 1024.f) + EPS);
#pragma unroll
    for (int j = 0; j < 4; ++j) {
        const int c = j * 256 + lane * 4;
        const float4 w = *(const float4*)(lnf_w + c);
        *(float4*)(out + (size_t)t * 1024 + c) = make_float4(acc[j].x * rs * w.x, acc[j].y * rs * w.y, acc[j].z * rs * w.z, acc[j].w * rs * w.w);
    }
}

constexpr int LDT = 136;
constexpr float QSCALE = 0.08838834764831845f;
constexpr size_t CH = 128 * 128;

__device__ __forceinline__ f32x4 mfma16(bf16x8 a, bf16x8 b, f32x4 c) { return __builtin_amdgcn_mfma_f32_16x16x32_bf16(a, b, c, 0, 0, 0); }
__device__ __forceinline__ uint2 pack4(float a, float b, float c, float d) {
    uint2 r; r.x = (unsigned)f2bf(a) | ((unsigned)f2bf(b) << 16); r.y = (unsigned)f2bf(c) | ((unsigned)f2bf(d) << 16); return r;
}
__device__ __forceinline__ int lrow(int i) {
    const int m = i - 1, a = m >> 2, b = m & 3;
    return i <= 0 ? 0 : 8 * a * (a + 1) + 4 * b * (a + 1);
}
constexpr int LROW_TOTAL = 8320;

__device__ __forceinline__ void conv_norm_rows(const bf16_t* __restrict__ projb, int t0, int colbase, const float* cw, bf16_t (*tile)[LDT], bf16_t* gout) {
    const int tid = threadIdx.x, i = tid >> 1, hf = tid & 1;
    float vals[64];
    float ss = 0.f;
#pragma unroll
    for (int g = 0; g < 8; ++g) {
        float acc[8];
#pragma unroll
        for (int k = 0; k < 8; ++k) acc[k] = 0.f;
#pragma unroll
        for (int j = 0; j < 4; ++j) {
            const int tt = t0 + i - 3 + j;
            if (tt >= 0) {
                const uint4 raw = *(const uint4*)(projb + (size_t)tt * NPROJ + colbase + hf * 64 + g * 8);
                const float4 w0 = *(const float4*)(cw + j * 128 + hf * 64 + g * 8), w1 = *(const float4*)(cw + j * 128 + hf * 64 + g * 8 + 4);
                acc[0] += w0.x * __uint_as_float(raw.x << 16); acc[1] += w0.y * __uint_as_float(raw.x & 0xffff0000u);
                acc[2] += w0.z * __uint_as_float(raw.y << 16); acc[3] += w0.w * __uint_as_float(raw.y & 0xffff0000u);
                acc[4] += w1.x * __uint_as_float(raw.z << 16); acc[5] += w1.y * __uint_as_float(raw.z & 0xffff0000u);
                acc[6] += w1.z * __uint_as_float(raw.w << 16); acc[7] += w1.w * __uint_as_float(raw.w & 0xffff0000u);
            }
        }
#pragma unroll
        for (int k = 0; k < 8; ++k) { const float s = silu(acc[k]); vals[g * 8 + k] = s; ss += s * s; }
    }
    ss += __shfl_xor(ss, 1);
    const float rs = rsqrtf(ss + EPS);
#pragma unroll
    for (int g = 0; g < 8; ++g) {
        const uint2 p0 = pack4(vals[g * 8] * rs, vals[g * 8 + 1] * rs, vals[g * 8 + 2] * rs, vals[g * 8 + 3] * rs);
        const uint2 p1 = pack4(vals[g * 8 + 4] * rs, vals[g * 8 + 5] * rs, vals[g * 8 + 6] * rs, vals[g * 8 + 7] * rs);
        const uint4 o = make_uint4(p0.x, p0.y, p1.x, p1.y);
        *(uint4*)&tile[i][hf * 64 + g * 8] = o;
        if (gout) *(uint4*)(gout + (size_t)(t0 + i) * 512 + hf * 64 + g * 8) = o;
    }
}

__device__ __forceinline__ void gdn_phaseA(int item, unsigned char* smem, const bf16_t* __restrict__ projb, const float* __restrict__ conv_w,
                                           const float* __restrict__ gdec, const float* __restrict__ beta,
                                           bf16_t* __restrict__ UT, bf16_t* __restrict__ Wm, bf16_t* __restrict__ KstT, bf16_t* __restrict__ kn, float* __restrict__ gcb) {
    const int h = item & 3, n = item >> 2, t0 = n * 128;
    const int tid = threadIdx.x, lane = tid & 63, w = tid >> 6;
    { int zoff = 0; asm volatile("" : "+s"(zoff)); smem += zoff; }
    float* gs = (float*)smem;
    float* gcs = gs + 128;
    float* bts = gcs + 128;
    float* cw = bts + 128;
    float* Lp = cw + 512;
    bf16_t (*Kt)[LDT] = (bf16_t(*)[LDT])(smem + 3584 + LROW_TOTAL * 4);
    if (tid < 128) { gs[tid] = gdec[(size_t)(t0 + tid) * 4 + h]; bts[tid] = beta[(size_t)(t0 + tid) * 4 + h]; }
    for (int u = tid; u < 512; u += 256) cw[u] = conv_w[(u >> 7) * 1536 + 512 + h * 128 + (u & 127)];
    __syncthreads();
    if (tid < 128) {
        float s = 0.f;
        for (int j = 0; j <= tid; ++j) s += gs[j];
        gcs[tid] = s;
        gcb[(size_t)(h * 128 + n) * 128 + tid] = s;
    }
    conv_norm_rows(projb, t0, C_GK + h * 128, cw, Kt, kn + h * 128);
    __syncthreads();
    {
        const int wr = w >> 1, wc = w & 1, r = lane & 15, quad = lane >> 4;
        if (!(wr == 0 && wc == 1)) {
            f32x4 acc[4][4];
#pragma unroll
            for (int i = 0; i < 4; ++i)
#pragma unroll
                for (int j = 0; j < 4; ++j) acc[i][j] = (f32x4){0.f, 0.f, 0.f, 0.f};
#pragma unroll
            for (int ks = 0; ks < 4; ++ks) {
                bf16x8 a[4], b[4];
#pragma unroll
                for (int i = 0; i < 4; ++i) a[i] = *(const bf16x8*)&Kt[wr * 64 + i * 16 + r][ks * 32 + quad * 8];
#pragma unroll
                for (int j = 0; j < 4; ++j) b[j] = *(const bf16x8*)&Kt[wc * 64 + j * 16 + r][ks * 32 + quad * 8];
#pragma unroll
                for (int i = 0; i < 4; ++i)
#pragma unroll
                    for (int j = 0; j < 4; ++j) acc[i][j] = mfma16(b[j], a[i], acc[i][j]);
            }
#pragma unroll
            for (int i = 0; i < 4; ++i) {
                const int row = wr * 64 + i * 16 + r;
                const float bi = bts[row], gi = gcs[row];
                const int rs = lrow(row);
#pragma unroll
                for (int j = 0; j < 4; ++j) {
                    const int c0 = wc * 64 + j * 16 + quad * 4;
                    if (c0 < row) {
                        float4 o;
                        o.x = (c0 + 0 < row) ? bi * acc[i][j][0] * __expf(gi - gcs[c0 + 0]) : 0.f;
                        o.y = (c0 + 1 < row) ? bi * acc[i][j][1] * __expf(gi - gcs[c0 + 1]) : 0.f;
                        o.z = (c0 + 2 < row) ? bi * acc[i][j][2] * __expf(gi - gcs[c0 + 2]) : 0.f;
                        o.w = (c0 + 3 < row) ? bi * acc[i][j][3] * __expf(gi - gcs[c0 + 3]) : 0.f;
                        *(float4*)&Lp[rs + c0] = o;
                    }
                }
            }
        }
    }
    __syncthreads();
    float x[128];
    const size_t cbase = (size_t)(h * 128 + n) * CH;
    if (tid < 128) {
        const int e = tid;
        const bf16_t* vp = projb + C_GV + h * 128 + e;
        const float w0 = conv_w[0 * 1536 + 1024 + h * 128 + e], w1 = conv_w[1 * 1536 + 1024 + h * 128 + e];
        const float w2 = conv_w[2 * 1536 + 1024 + h * 128 + e], w3 = conv_w[3 * 1536 + 1024 + h * 128 + e];
        float r0 = (t0 >= 3) ? bf2f(vp[(size_t)(t0 - 3) * NPROJ]) : 0.f;
        float r1 = (t0 >= 2) ? bf2f(vp[(size_t)(t0 - 2) * NPROJ]) : 0.f;
        float r2 = (t0 >= 1) ? bf2f(vp[(size_t)(t0 - 1) * NPROJ]) : 0.f;
#pragma unroll
        for (int i = 0; i < 128; ++i) {
            const float r3 = bf2f(vp[(size_t)(t0 + i) * NPROJ]);
            x[i] = bts[i] * silu(w0 * r0 + w1 * r1 + w2 * r2 + w3 * r3);
            r0 = r1; r1 = r2; r2 = r3;
        }
    } else {
        const int d = tid - 128;
#pragma unroll
        for (int i = 0; i < 128; ++i) x[i] = bts[i] * __expf(gcs[i]) * bf2f(Kt[i][d]);
    }
    int zo = 0;
#pragma unroll
    for (int i = 1; i < 128; ++i) {
        float s = x[i];
        asm volatile("" : "+v"(zo) : "v"(x[i - 1]));
        const float* Lr = Lp + zo;
#pragma unroll
        for (int g = 0; g < (i + 3) / 4; ++g) {
            const float4 l = *(const float4*)&Lr[lrow(i) + 4 * g];
            if (4 * g + 0 < i) s -= l.x * x[4 * g + 0];
            if (4 * g + 1 < i) s -= l.y * x[4 * g + 1];
            if (4 * g + 2 < i) s -= l.z * x[4 * g + 2];
            if (4 * g + 3 < i) s -= l.w * x[4 * g + 3];
        }
        x[i] = s;
    }
    if (tid < 128) {
        bf16_t* up = UT + cbase + (size_t)tid * 128;
#pragma unroll
        for (int g = 0; g < 16; ++g) {
            const uint2 p0 = pack4(x[8 * g], x[8 * g + 1], x[8 * g + 2], x[8 * g + 3]), p1 = pack4(x[8 * g + 4], x[8 * g + 5], x[8 * g + 6], x[8 * g + 7]);
            *(uint4*)(up + 8 * g) = make_uint4(p0.x, p0.y, p1.x, p1.y);
        }
    } else {
        const int d = tid - 128;
        const float gl = gcs[127];
        bf16_t* kp = KstT + cbase + (size_t)d * 128;
#pragma unroll
        for (int g = 0; g < 16; ++g) {
            float kv[8];
#pragma unroll
            for (int k = 0; k < 8; ++k) kv[k] = bf2f(Kt[8 * g + k][d]) * __expf(gl - gcs[8 * g + k]);
            const uint2 p0 = pack4(kv[0], kv[1], kv[2], kv[3]), p1 = pack4(kv[4], kv[5], kv[6], kv[7]);
            *(uint4*)(kp + 8 * g) = make_uint4(p0.x, p0.y, p1.x, p1.y);
        }
    }
    __syncthreads();
    if (tid >= 128) {
        const int d = tid - 128;
#pragma unroll
        for (int i = 0; i < 128; ++i) Kt[i][d] = f2bf(x[i]);
    }
    __syncthreads();
#pragma unroll
    for (int j = 0; j < 8; ++j) {
        const int c = tid + 256 * j, row = c >> 4, cc = c & 15;
        *(uint4*)(Wm + cbase + (size_t)row * 128 + cc * 8) = *(const uint4*)&Kt[row][cc * 8];
    }
    __syncthreads();
}

struct ScanFrags { bf16x8 aw[2][4]; bf16x8 ak[2][4]; uint2 u[2][2]; float dec; };
__device__ __forceinline__ void scan_load(ScanFrags& f, int h, int n, int c, int w, int r, int quad,
                                          const bf16_t* __restrict__ UT, const bf16_t* __restrict__ Wm, const bf16_t* __restrict__ KstT, const float* __restrict__ gcb) {
    const size_t cbase = (size_t)(h * 128 + n) * CH;
#pragma unroll
    for (int mt = 0; mt < 2; ++mt)
#pragma unroll
        for (int ks = 0; ks < 4; ++ks) {
            const size_t o = cbase + (size_t)(32 * w + 16 * mt + r) * 128 + ks * 32 + quad * 8;
            f.aw[mt][ks] = *(const bf16x8*)(Wm + o);
            f.ak[mt][ks] = *(const bf16x8*)(KstT + o);
        }
#pragma unroll
    for (int mt = 0; mt < 2; ++mt)
#pragma unroll
        for (int nt = 0; nt < 2; ++nt)
            f.u[mt][nt] = *(const uint2*)(UT + cbase + (size_t)(32 * c + 16 * nt + r) * 128 + 32 * w + 16 * mt + quad * 4);
    f.dec = __expf(gcb[(size_t)(h * 128 + n) * 128 + 127]);
}
__device__ __forceinline__ void scan_step(const ScanFrags& f, f32x4 (&s)[2][2], int h, int n, int c, int w, int r, int quad,
                                          bf16_t (*ST)[LDT], bf16_t (*VT)[LDT], bf16_t* __restrict__ VnT, bf16_t* __restrict__ Sst) {
    f32x4 xa[2][2];
#pragma unroll
    for (int mt = 0; mt < 2; ++mt)
#pragma unroll
        for (int nt = 0; nt < 2; ++nt) xa[mt][nt] = (f32x4){0.f, 0.f, 0.f, 0.f};
#pragma unroll
    for (int ks = 0; ks < 4; ++ks) {
        const bf16x8 b0 = *(const bf16x8*)&ST[r][ks * 32 + quad * 8], b1 = *(const bf16x8*)&ST[16 + r][ks * 32 + quad * 8];
#pragma unroll
        for (int mt = 0; mt < 2; ++mt) { xa[mt][0] = mfma16(f.aw[mt][ks], b0, xa[mt][0]); xa[mt][1] = mfma16(f.aw[mt][ks], b1, xa[mt][1]); }
    }
    const size_t cbase = (size_t)(h * 128 + n) * CH;
#pragma unroll
    for (int mt = 0; mt < 2; ++mt)
#pragma unroll
        for (int nt = 0; nt < 2; ++nt) {
            const uint2 uu = f.u[mt][nt];
            const uint2 p = pack4(__uint_as_float(uu.x << 16) - xa[mt][nt][0], __uint_as_float(uu.x & 0xffff0000u) - xa[mt][nt][1],
                                  __uint_as_float(uu.y << 16) - xa[mt][nt][2], __uint_as_float(uu.y & 0xffff0000u) - xa[mt][nt][3]);
            *(uint2*)&VT[16 * nt + r][32 * w + 16 * mt + quad * 4] = p;
            *(uint2*)(VnT + cbase + (size_t)(32 * c + 16 * nt + r) * 128 + 32 * w + 16 * mt + quad * 4) = p;
        }
    __syncthreads();
#pragma unroll
    for (int mt = 0; mt < 2; ++mt)
#pragma unroll
        for (int nt = 0; nt < 2; ++nt) s[mt][nt] *= f.dec;
#pragma unroll
    for (int ks = 0; ks < 4; ++ks) {
        const bf16x8 b0 = *(const bf16x8*)&VT[r][ks * 32 + quad * 8], b1 = *(const bf16x8*)&VT[16 + r][ks * 32 + quad * 8];
#pragma unroll
        for (int mt = 0; mt < 2; ++mt) { s[mt][0] = mfma16(f.ak[mt][ks], b0, s[mt][0]); s[mt][1] = mfma16(f.ak[mt][ks], b1, s[mt][1]); }
    }
#pragma unroll
    for (int mt = 0; mt < 2; ++mt)
#pragma unroll
        for (int nt = 0; nt < 2; ++nt) {
            const uint2 p = pack4(s[mt][nt][0], s[mt][nt][1], s[mt][nt][2], s[mt][nt][3]);
            *(uint2*)&ST[16 * nt + r][32 * w + 16 * mt + quad * 4] = p;
            if (n + 1 < 128) *(uint2*)(Sst + cbase + CH + (size_t)(32 * c + 16 * nt + r) * 128 + 32 * w + 16 * mt + quad * 4) = p;
        }
    __syncthreads();
}
__device__ __forceinline__ void gdn_scan(int b, unsigned char* smem, const bf16_t* __restrict__ UT, const bf16_t* __restrict__ Wm, const bf16_t* __restrict__ KstT,
                                         const float* __restrict__ gcb, bf16_t* __restrict__ VnT, bf16_t* __restrict__ Sst) {
    const int h = b >> 2, c = b & 3;
    const int tid = threadIdx.x, lane = tid & 63, w = tid >> 6, r = lane & 15, quad = lane >> 4;
    bf16_t (*ST)[LDT] = (bf16_t(*)[LDT])smem;
    bf16_t (*VT)[LDT] = (bf16_t(*)[LDT])(smem + 32 * LDT * 2);
    for (int u = tid; u < 32 * LDT / 2; u += 256) ((unsigned*)smem)[u] = 0u;
    {
        const size_t cb0 = (size_t)(h * 128) * CH;
        for (int u = tid; u < 32 * 16; u += 256) *(uint4*)(Sst + cb0 + (size_t)(32 * c + (u >> 4)) * 128 + (u & 15) * 8) = make_uint4(0u, 0u, 0u, 0u);
    }
    f32x4 s[2][2];
#pragma unroll
    for (int mt = 0; mt < 2; ++mt)
#pragma unroll
        for (int nt = 0; nt < 2; ++nt) s[mt][nt] = (f32x4){0.f, 0.f, 0.f, 0.f};
    __syncthreads();
    ScanFrags f0, f1;
    scan_load(f0, h, 0, c, w, r, quad, UT, Wm, KstT, gcb);
    for (int n = 0; n < 128; n += 2) {
        scan_load(f1, h, n + 1, c, w, r, quad, UT, Wm, KstT, gcb);
        scan_step(f0, s, h, n, c, w, r, quad, ST, VT, VnT, Sst);
        scan_load(f0, h, (n + 2 < 128) ? n + 2 : 127, c, w, r, quad, UT, Wm, KstT, gcb);
        scan_step(f1, s, h, n + 1, c, w, r, quad, ST, VT, VnT, Sst);
    }
}

__device__ __forceinline__ void gdn_phaseC(int item, unsigned char* smem, const bf16_t* __restrict__ projb, const float* __restrict__ conv_w, const bf16_t* __restrict__ kn,
                                           const float* __restrict__ gcb, const bf16_t* __restrict__ VnT, const bf16_t* __restrict__ Sst,
                                           const float* __restrict__ gdn_norm_w, bf16_t* __restrict__ mixed) {
    const int h = item & 3, n = item >> 2, t0 = n * 128;
    const int tid = threadIdx.x, lane = tid & 63, w = tid >> 6;
    const int wr = w >> 1, wc = w & 1, r = lane & 15, quad = lane >> 4;
    { int zoff = 0; asm volatile("" : "+s"(zoff)); smem += zoff; }
    float* gcs = (float*)smem;
    float* cw = gcs + 128;
    float* red = cw + 512;
    bf16_t (*Qt)[LDT] = (bf16_t(*)[LDT])(smem + 3584);
    bf16_t (*Kt)[LDT] = (bf16_t(*)[LDT])(smem + 3584 + 128 * LDT * 2);
    const size_t cbase = (size_t)(h * 128 + n) * CH;
    if (tid < 128) gcs[tid] = gcb[(size_t)(h * 128 + n) * 128 + tid];
    for (int u = tid; u < 512; u += 256) cw[u] = conv_w[(u >> 7) * 1536 + h * 128 + (u & 127)];
#pragma unroll
    for (int j = 0; j < 8; ++j) {
        const int c = tid + 256 * j, row = c >> 4, cc = c & 15;
        *(uint4*)&Kt[row][cc * 8] = *(const uint4*)(kn + (size_t)(t0 + row) * 512 + h * 128 + cc * 8);
    }
    __syncthreads();
    conv_norm_rows(projb, t0, C_GQ + h * 128, cw, Qt, nullptr);
    __syncthreads();
    f32x4 acc[4][4];
#pragma unroll
    for (int i = 0; i < 4; ++i)
#pragma unroll
        for (int j = 0; j < 4; ++j) acc[i][j] = (f32x4){0.f, 0.f, 0.f, 0.f};
    if (!(wr == 0 && wc == 1)) {
#pragma unroll
        for (int ks = 0; ks < 4; ++ks) {
            bf16x8 a[4], b[4];
#pragma unroll
            for (int i = 0; i < 4; ++i) a[i] = *(const bf16x8*)&Qt[wr * 64 + i * 16 + r][ks * 32 + quad * 8];
#pragma unroll
            for (int j = 0; j < 4; ++j) b[j] = *(const bf16x8*)&Kt[wc * 64 + j * 16 + r][ks * 32 + quad * 8];
#pragma unroll
            for (int i = 0; i < 4; ++i)
#pragma unroll
                for (int j = 0; j < 4; ++j) acc[i][j] = mfma16(b[j], a[i], acc[i][j]);
        }
    }
    __syncthreads();
#pragma unroll
    for (int i = 0; i < 4; ++i) {
        const int row = wr * 64 + i * 16 + r;
        const float gi = gcs[row];
#pragma unroll
        for (int j = 0; j < 4; ++j) {
            const int c0 = wc * 64 + j * 16 + quad * 4;
            float o[4];
#pragma unroll
            for (int v = 0; v < 4; ++v) o[v] = (c0 + v <= row) ? acc[i][j][v] * QSCALE * __expf(gi - gcs[c0 + v]) : 0.f;
            *(uint2*)&Kt[row][c0] = pack4(o[0], o[1], o[2], o[3]);
        }
    }
    __syncthreads();
#pragma unroll
    for (int i = 0; i < 4; ++i)
#pragma unroll
        for (int j = 0; j < 4; ++j) acc[i][j] = (f32x4){0.f, 0.f, 0.f, 0.f};
#pragma unroll
    for (int ks = 0; ks < 4; ++ks) {
        bf16x8 a[4], b[4];
#pragma unroll
        for (int i = 0; i < 4; ++i) a[i] = *(const bf16x8*)&Qt[wr * 64 + i * 16 + r][ks * 32 + quad * 8];
#pragma unroll
        for (int j = 0; j < 4; ++j) b[j] = *(const bf16x8*)(Sst + cbase + (size_t)(wc * 64 + j * 16 + r) * 128 + ks * 32 + quad * 8);
#pragma unroll
        for (int i = 0; i < 4; ++i)
#pragma unroll
            for (int j = 0; j < 4; ++j) acc[i][j] = mfma16(b[j], a[i], acc[i][j]);
    }
#pragma unroll
    for (int i = 0; i < 4; ++i) {
        const float sc = QSCALE * __expf(gcs[wr * 64 + i * 16 + r]);
#pragma unroll
        for (int j = 0; j < 4; ++j) acc[i][j] *= sc;
    }
#pragma unroll
    for (int ks = 0; ks < 4; ++ks) {
        bf16x8 a[4], b[4];
#pragma unroll
        for (int i = 0; i < 4; ++i) a[i] = *(const bf16x8*)&Kt[wr * 64 + i * 16 + r][ks * 32 + quad * 8];
#pragma unroll
        for (int j = 0; j < 4; ++j) b[j] = *(const bf16x8*)(VnT + cbase + (size_t)(wc * 64 + j * 16 + r) * 128 + ks * 32 + quad * 8);
#pragma unroll
        for (int i = 0; i < 4; ++i)
#pragma unroll
            for (int j = 0; j < 4; ++j) acc[i][j] = mfma16(b[j], a[i], acc[i][j]);
    }
#pragma unroll
    for (int i = 0; i < 4; ++i) {
        float ss = 0.f;
#pragma unroll
        for (int j = 0; j < 4; ++j)
#pragma unroll
            for (int v = 0; v < 4; ++v) ss += acc[i][j][v] * acc[i][j][v];
        ss += __shfl_xor(ss, 16); ss += __shfl_xor(ss, 32);
        if (quad == 0) red[wc * 128 + wr * 64 + i * 16 + r] = ss;
    }
    __syncthreads();
#pragma unroll
    for (int i = 0; i < 4; ++i) {
        const int row = wr * 64 + i * 16 + r;
        const float rs = rsqrtf((red[row] + red[128 + row]) * (1.f / 128.f) + EPS);
#pragma unroll
        for (int j = 0; j < 4; ++j) {
            const int e0 = wc * 64 + j * 16 + quad * 4;
            const uint2 gz = *(const uint2*)(projb + (size_t)(t0 + row) * NPROJ + C_GZ + h * 128 + e0);
            const float4 nw = *(const float4*)(gdn_norm_w + e0);
            const uint2 p = pack4(acc[i][j][0] * rs * nw.x * silu(__uint_as_float(gz.x << 16)), acc[i][j][1] * rs * nw.y * silu(__uint_as_float(gz.x & 0xffff0000u)),
                                  acc[i][j][2] * rs * nw.z * silu(__uint_as_float(gz.y << 16)), acc[i][j][3] * rs * nw.w * silu(__uint_as_float(gz.y & 0xffff0000u)));
            *(uint2*)(mixed + (size_t)(t0 + row) * 1024 + 512 + h * 128 + e0) = p;
        }
    }
    __syncthreads();
}


__device__ __forceinline__ void ret_phaseA(int item, unsigned char* smem, const bf16_t* __restrict__ projb,
                                           bf16_t* __restrict__ rqr, bf16_t* __restrict__ rkr, bf16_t* __restrict__ VTg, float* __restrict__ kvT) {
    const int h = item & 3, n = item >> 2, t0 = n * 128;
    const int tid = threadIdx.x, lane = tid & 63, w = tid >> 6, r = lane & 15, quad = lane >> 4;
    { int zoff = 0; asm volatile("" : "+s"(zoff)); smem += zoff; }
    bf16_t (*VT)[LDT] = (bf16_t(*)[LDT])smem;
    bf16_t (*KT)[LDT] = (bf16_t(*)[LDT])(smem + 128 * LDT * 2);
    const float lg2 = log2f(1.f - exp2f(-5.f - (float)h));
    {
        const int i = tid >> 1, hf = tid & 1, t = t0 + i;
        const bf16_t* pq = projb + (size_t)t * NPROJ + C_RQ + h * 64 + hf * 16;
        const bf16_t* pk = projb + (size_t)t * NPROJ + C_RK + h * 64 + hf * 16;
        uint4 ql[2], qh[2], kl[2], kh[2];
        ql[0] = *(const uint4*)pq; ql[1] = *(const uint4*)(pq + 8); qh[0] = *(const uint4*)(pq + 32); qh[1] = *(const uint4*)(pq + 40);
        kl[0] = *(const uint4*)pk; kl[1] = *(const uint4*)(pk + 8); kh[0] = *(const uint4*)(pk + 32); kh[1] = *(const uint4*)(pk + 40);
        const unsigned* qlw = (const unsigned*)ql; const unsigned* qhw = (const unsigned*)qh; const unsigned* klw = (const unsigned*)kl; const unsigned* khw = (const unsigned*)kh;
        const float kdec = exp2f((float)(127 - i) * lg2);
        unsigned oql[8], oqh[8], okl[8], okh[8];
#pragma unroll
        for (int p = 0; p < 8; ++p) {
            float q1[2], q2[2], k1[2], k2[2];
#pragma unroll
            for (int s = 0; s < 2; ++s) {
                const int j = hf * 16 + 2 * p + s;
                double u = (double)t * INVREV[j];
                u -= rint(u);
                const float fr = (float)u;
                const float sn = __builtin_amdgcn_sinf(fr), cs = __builtin_amdgcn_cosf(fr);
                const float qa = s ? __uint_as_float(qlw[p] & 0xffff0000u) : __uint_as_float(qlw[p] << 16);
                const float qb = s ? __uint_as_float(qhw[p] & 0xffff0000u) : __uint_as_float(qhw[p] << 16);
                const float ka = s ? __uint_as_float(klw[p] & 0xffff0000u) : __uint_as_float(klw[p] << 16);
                const float kb = s ? __uint_as_float(khw[p] & 0xffff0000u) : __uint_as_float(khw[p] << 16);
                q1[s] = qa * cs - qb * sn; q2[s] = qa * sn + qb * cs;
                k1[s] = (ka * cs - kb * sn) * 0.125f; k2[s] = (ka * sn + kb * cs) * 0.125f;
                KT[j][i] = f2bf(k1[s] * kdec);
                KT[j + 32][i] = f2bf(k2[s] * kdec);
            }
            oql[p] = (unsigned)f2bf(q1[0]) | ((unsigned)f2bf(q1[1]) << 16); oqh[p] = (unsigned)f2bf(q2[0]) | ((unsigned)f2bf(q2[1]) << 16);
            okl[p] = (unsigned)f2bf(k1[0]) | ((unsigned)f2bf(k1[1]) << 16); okh[p] = (unsigned)f2bf(k2[0]) | ((unsigned)f2bf(k2[1]) << 16);
        }
        bf16_t* oq = rqr + (size_t)t * 256 + h * 64 + hf * 16;
        bf16_t* ok = rkr + (size_t)t * 256 + h * 64 + hf * 16;
        *(uint4*)oq = make_uint4(oql[0], oql[1], oql[2], oql[3]); *(uint4*)(oq + 8) = make_uint4(oql[4], oql[5], oql[6], oql[7]);
        *(uint4*)(oq + 32) = make_uint4(oqh[0], oqh[1], oqh[2], oqh[3]); *(uint4*)(oq + 40) = make_uint4(oqh[4], oqh[5], oqh[6], oqh[7]);
        *(uint4*)ok = make_uint4(okl[0], okl[1], okl[2], okl[3]); *(uint4*)(ok + 8) = make_uint4(okl[4], okl[5], okl[6], okl[7]);
        *(uint4*)(ok + 32) = make_uint4(okh[0], okh[1], okh[2], okh[3]); *(uint4*)(ok + 40) = make_uint4(okh[4], okh[5], okh[6], okh[7]);
        const bf16_t* pv = projb + (size_t)t * NPROJ + C_RV + h * 128 + hf * 64;
#pragma unroll
        for (int g = 0; g < 8; ++g) {
            const uint4 raw = *(const uint4*)(pv + g * 8);
            const int e = hf * 64 + g * 8;
            VT[e + 0][i] = (bf16_t)(raw.x & 0xffffu); VT[e + 1][i] = (bf16_t)(raw.x >> 16);
            VT[e + 2][i] = (bf16_t)(raw.y & 0xffffu); VT[e + 3][i] = (bf16_t)(raw.y >> 16);
            VT[e + 4][i] = (bf16_t)(raw.z & 0xffffu); VT[e + 5][i] = (bf16_t)(raw.z >> 16);
            VT[e + 6][i] = (bf16_t)(raw.w & 0xffffu); VT[e + 7][i] = (bf16_t)(raw.w >> 16);
        }
    }
    __syncthreads();
    const size_t cbase = (size_t)(h * 128 + n) * CH;
#pragma unroll
    for (int j = 0; j < 8; ++j) {
        const int c = tid + 256 * j, row = c >> 4, cc = c & 15;
        *(uint4*)(VTg + cbase + (size_t)row * 128 + cc * 8) = *(const uint4*)&VT[row][cc * 8];
    }
    f32x4 acc[2][4];
#pragma unroll
    for (int mt = 0; mt < 2; ++mt)
#pragma unroll
        for (int nt = 0; nt < 4; ++nt) acc[mt][nt] = (f32x4){0.f, 0.f, 0.f, 0.f};
#pragma unroll
    for (int ks = 0; ks < 4; ++ks) {
        bf16x8 a[2], b[4];
#pragma unroll
        for (int mt = 0; mt < 2; ++mt) a[mt] = *(const bf16x8*)&VT[32 * w + 16 * mt + r][ks * 32 + quad * 8];
#pragma unroll
        for (int nt = 0; nt < 4; ++nt) b[nt] = *(const bf16x8*)&KT[16 * nt + r][ks * 32 + quad * 8];
#pragma unroll
        for (int mt = 0; mt < 2; ++mt)
#pragma unroll
            for (int nt = 0; nt < 4; ++nt) acc[mt][nt] = mfma16(b[nt], a[mt], acc[mt][nt]);
    }
    float* kvp = kvT + (size_t)(h * 128 + n) * 8192;
#pragma unroll
    for (int mt = 0; mt < 2; ++mt)
#pragma unroll
        for (int nt = 0; nt < 4; ++nt)
            *(float4*)(kvp + (size_t)(32 * w + 16 * mt + r) * 64 + 16 * nt + quad * 4) = make_float4(acc[mt][nt][0], acc[mt][nt][1], acc[mt][nt][2], acc[mt][nt][3]);
    __syncthreads();
}

__device__ __forceinline__ void ret_scan(int gid, const float* __restrict__ kvT, bf16_t* __restrict__ Srt) {
    const int h = gid >> 13, rem = gid & 8191;
    const float Gam = exp2f(128.f * log2f(1.f - exp2f(-5.f - (float)h)));
    float S = 0.f;
    const float* kp = kvT + (size_t)h * 128 * 8192 + rem;
    bf16_t* sp = Srt + (size_t)h * 128 * 8192 + rem;
    for (int n0 = 0; n0 < 128; n0 += 8) {
        float kv[8];
#pragma unroll
        for (int i = 0; i < 8; ++i) kv[i] = kp[(size_t)(n0 + i) * 8192];
#pragma unroll
        for (int i = 0; i < 8; ++i) { sp[(size_t)(n0 + i) * 8192] = f2bf(S); S = Gam * S + kv[i]; }
    }
}

__device__ __forceinline__ void ret_phaseC(int item, unsigned char* smem, const bf16_t* __restrict__ projb, const bf16_t* __restrict__ rqr, const bf16_t* __restrict__ rkr,
                                           const bf16_t* __restrict__ VTg, const bf16_t* __restrict__ Srt, const float* __restrict__ ret_norm_w, bf16_t* __restrict__ mixed) {
    const int h = item & 3, n = item >> 2, t0 = n * 128;
    const int tid = threadIdx.x, lane = tid & 63, w = tid >> 6;
    const int wr = w >> 1, wc = w & 1, r = lane & 15, quad = lane >> 4;
    { int zoff = 0; asm volatile("" : "+s"(zoff)); smem += zoff; }
    float* red = (float*)smem;
    bf16_t (*Qr)[GLD] = (bf16_t(*)[GLD])(smem + 2048);
    bf16_t (*Kr)[GLD] = (bf16_t(*)[GLD])(smem + 2048 + 128 * GLD * 2);
    bf16_t (*Sc)[LDT] = (bf16_t(*)[LDT])(smem + 2048 + 2 * 128 * GLD * 2);
    const float lg2 = log2f(1.f - exp2f(-5.f - (float)h));
#pragma unroll
    for (int j = 0; j < 4; ++j) {
        const int c = tid + 256 * j, row = c >> 3, cc = c & 7;
        *(uint4*)&Qr[row][cc * 8] = *(const uint4*)(rqr + (size_t)(t0 + row) * 256 + h * 64 + cc * 8);
        *(uint4*)&Kr[row][cc * 8] = *(const uint4*)(rkr + (size_t)(t0 + row) * 256 + h * 64 + cc * 8);
    }
    __syncthreads();
    f32x4 acc[4][4];
#pragma unroll
    for (int i = 0; i < 4; ++i)
#pragma unroll
        for (int j = 0; j < 4; ++j) acc[i][j] = (f32x4){0.f, 0.f, 0.f, 0.f};
    if (!(wr == 0 && wc == 1)) {
#pragma unroll
        for (int ks = 0; ks < 2; ++ks) {
            bf16x8 a[4], b[4];
#pragma unroll
            for (int i = 0; i < 4; ++i) a[i] = *(const bf16x8*)&Qr[wr * 64 + i * 16 + r][ks * 32 + quad * 8];
#pragma unroll
            for (int j = 0; j < 4; ++j) b[j] = *(const bf16x8*)&Kr[wc * 64 + j * 16 + r][ks * 32 + quad * 8];
#pragma unroll
            for (int i = 0; i < 4; ++i)
#pragma unroll
                for (int j = 0; j < 4; ++j) acc[i][j] = mfma16(b[j], a[i], acc[i][j]);
        }
    }
#pragma unroll
    for (int i = 0; i < 4; ++i) {
        const int row = wr * 64 + i * 16 + r;
#pragma unroll
        for (int j = 0; j < 4; ++j) {
            const int c0 = wc * 64 + j * 16 + quad * 4;
            float o[4];
#pragma unroll
            for (int v = 0; v < 4; ++v) o[v] = (c0 + v <= row) ? acc[i][j][v] * exp2f((float)(row - c0 - v) * lg2) : 0.f;
            *(uint2*)&Sc[row][c0] = pack4(o[0], o[1], o[2], o[3]);
        }
    }
    __syncthreads();
    const size_t cbase = (size_t)(h * 128 + n) * CH;
    const bf16_t* sp = Srt + (size_t)(h * 128 + n) * 8192;
#pragma unroll
    for (int i = 0; i < 4; ++i)
#pragma unroll
        for (int j = 0; j < 4; ++j) acc[i][j] = (f32x4){0.f, 0.f, 0.f, 0.f};
#pragma unroll
    for (int ks = 0; ks < 2; ++ks) {
        bf16x8 a[4], b[4];
#pragma unroll
        for (int i = 0; i < 4; ++i) a[i] = *(const bf16x8*)&Qr[wr * 64 + i * 16 + r][ks * 32 + quad * 8];
#pragma unroll
        for (int j = 0; j < 4; ++j) b[j] = *(const bf16x8*)(sp + (size_t)(wc * 64 + j * 16 + r) * 64 + ks * 32 + quad * 8);
#pragma unroll
        for (int i = 0; i < 4; ++i)
#pragma unroll
            for (int j = 0; j < 4; ++j) acc[i][j] = mfma16(b[j], a[i], acc[i][j]);
    }
#pragma unroll
    for (int i = 0; i < 4; ++i) {
        const float sc = exp2f((float)(wr * 64 + i * 16 + r + 1) * lg2);
#pragma unroll
        for (int j = 0; j < 4; ++j) acc[i][j] *= sc;
    }
#pragma unroll
    for (int ks = 0; ks < 4; ++ks) {
        bf16x8 a[4], b[4];
#pragma unroll
        for (int i = 0; i < 4; ++i) a[i] = *(const bf16x8*)&Sc[wr * 64 + i * 16 + r][ks * 32 + quad * 8];
#pragma unroll
        for (int j = 0; j < 4; ++j) b[j] = *(const bf16x8*)(VTg + cbase + (size_t)(wc * 64 + j * 16 + r) * 128 + ks * 32 + quad * 8);
#pragma unroll
        for (int i = 0; i < 4; ++i)
#pragma unroll
            for (int j = 0; j < 4; ++j) acc[i][j] = mfma16(b[j], a[i], acc[i][j]);
    }
#pragma unroll
    for (int i = 0; i < 4; ++i) {
        float s1 = 0.f, s2 = 0.f;
#pragma unroll
        for (int j = 0; j < 4; ++j)
#pragma unroll
            for (int v = 0; v < 4; ++v) { s1 += acc[i][j][v]; s2 += acc[i][j][v] * acc[i][j][v]; }
        s1 += __shfl_xor(s1, 16); s1 += __shfl_xor(s1, 32);
        s2 += __shfl_xor(s2, 16); s2 += __shfl_xor(s2, 32);
        if (quad == 0) { red[wc * 128 + wr * 64 + i * 16 + r] = s1; red[256 + wc * 128 + wr * 64 + i * 16 + r] = s2; }
    }
    __syncthreads();
#pragma unroll
    for (int i = 0; i < 4; ++i) {
        const int row = wr * 64 + i * 16 + r;
        const float mu = (red[row] + red[128 + row]) * (1.f / 128.f);
        const float var = fmaxf((red[256 + row] + red[384 + row]) * (1.f / 128.f) - mu * mu, 0.f);
        const float rs = rsqrtf(var + EPS);
#pragma unroll
        for (int j = 0; j < 4; ++j) {
            const int e0 = wc * 64 + j * 16 + quad * 4;
            const uint2 gz = *(const uint2*)(projb + (size_t)(t0 + row) * NPROJ + C_RG + h * 128 + e0);
            const float4 nw = *(const float4*)(ret_norm_w + h * 128 + e0);
            const uint2 p = pack4((acc[i][j][0] - mu) * rs * nw.x * silu(__uint_as_float(gz.x << 16)), (acc[i][j][1] - mu) * rs * nw.y * silu(__uint_as_float(gz.x & 0xffff0000u)),
                                  (acc[i][j][2] - mu) * rs * nw.z * silu(__uint_as_float(gz.y << 16)), (acc[i][j][3] - mu) * rs * nw.w * silu(__uint_as_float(gz.y & 0xffff0000u)));
            *(uint2*)(mixed + (size_t)(t0 + row) * 1024 + h * 128 + e0) = p;
        }
    }
    __syncthreads();
}


__device__ __forceinline__ void k_rope(int bid, const bf16_t* __restrict__ projb, bf16_t* __restrict__ rqr, bf16_t* __restrict__ rkr) {
    const int t = bid, tid = threadIdx.x;
    const int which = tid >> 7, h = (tid >> 5) & 3, j = tid & 31;
    const bf16_t* p = projb + (size_t)t * NPROJ + which * 256 + h * 64;
    const float a = bf2f(p[j]), b = bf2f(p[j + 32]);
    double u = (double)t * INVREV[j];
    u -= rint(u);
    const float fr = (float)u;
    const float sn = __builtin_amdgcn_sinf(fr), cs = __builtin_amdgcn_cosf(fr);
    const float sc = which ? 0.125f : 1.f;
    bf16_t* o = (which ? rkr : rqr) + (size_t)t * 256 + h * 64;
    o[j] = f2bf((a * cs - b * sn) * sc);
    o[j + 32] = f2bf((a * sn + b * cs) * sc);
}
__device__ __forceinline__ void k_mixnorm_ret(int bid, const float* __restrict__ o_r, const bf16_t* __restrict__ projb, const float* __restrict__ ret_norm_w, bf16_t* __restrict__ mixed) {
    const int gw = bid * 4 + (threadIdx.x >> 6), l = threadIdx.x & 63;
    const int t = gw >> 2, g = gw & 3;
    const float2 o = *(const float2*)(o_r + (size_t)t * 512 + g * 128 + 2 * l);
    const float mu = wave_sum(o.x + o.y) * (1.f / 128.f);
    const float d0 = o.x - mu, d1 = o.y - mu;
    const float var = wave_sum(d0 * d0 + d1 * d1) * (1.f / 128.f);
    const float rs = rsqrtf(var + EPS);
    const bf16_t* gp = projb + (size_t)t * NPROJ + C_RG + g * 128 + 2 * l;
    const float y0 = d0 * rs * ret_norm_w[g * 128 + 2 * l] * silu(bf2f(gp[0]));
    const float y1 = d1 * rs * ret_norm_w[g * 128 + 2 * l + 1] * silu(bf2f(gp[1]));
    bf16_t* mp = mixed + (size_t)t * 1024 + g * 128 + 2 * l;
    mp[0] = f2bf(y0); mp[1] = f2bf(y1);
}

constexpr float U_SCALE = 256.f, V_SCALE = 32.f;
__device__ __forceinline__ void k_tab8(int gid, const float* __restrict__ src, unsigned char* __restrict__ dst, float scale) {
    const float4* sp = (const float4*)(src + (size_t)gid * 16);
    unsigned wv[4];
#pragma unroll
    for (int m = 0; m < 4; ++m) {
        const float4 v = sp[m];
        int w = __builtin_amdgcn_cvt_pk_fp8_f32(v.x * scale, v.y * scale, 0, false);
        w = __builtin_amdgcn_cvt_pk_fp8_f32(v.z * scale, v.w * scale, w, true);
        wv[m] = (unsigned)w;
    }
    *(uint4*)(dst + (size_t)gid * 16) = make_uint4(wv[0], wv[1], wv[2], wv[3]);
}
typedef __attribute__((ext_vector_type(2))) float f32x2;
__device__ __forceinline__ float dot16_fp8(const uint4 r, const float (&h)[16]) {
    float d = 0.f;
    const unsigned wv[4] = {r.x, r.y, r.z, r.w};
#pragma unroll
    for (int m = 0; m < 4; ++m) {
        const f32x2 lo = __builtin_amdgcn_cvt_pk_f32_fp8((int)wv[m], false), hi = __builtin_amdgcn_cvt_pk_f32_fp8((int)wv[m], true);
        d += lo.x * h[4 * m] + lo.y * h[4 * m + 1] + hi.x * h[4 * m + 2] + hi.y * h[4 * m + 3];
    }
    return d;
}
__device__ __forceinline__ void axpy16_fp8(const uint4 r, float c, float (&a)[16]) {
    const unsigned wv[4] = {r.x, r.y, r.z, r.w};
#pragma unroll
    for (int m = 0; m < 4; ++m) {
        const f32x2 lo = __builtin_amdgcn_cvt_pk_f32_fp8((int)wv[m], false), hi = __builtin_amdgcn_cvt_pk_f32_fp8((int)wv[m], true);
        a[4 * m] += c * lo.x; a[4 * m + 1] += c * lo.y; a[4 * m + 2] += c * hi.x; a[4 * m + 3] += c * hi.y;
    }
}
__device__ __forceinline__ void k_peer8(int bid, const float* x2, const float* __restrict__ r2, const float* __restrict__ ln2_w,
                                        const int* __restrict__ sel_id, const float* __restrict__ sel_g,
                                        const unsigned char* __restrict__ u8, const unsigned char* __restrict__ v8, const float* __restrict__ lnf_w, float* out) {
    const int t = bid * 4 + (threadIdx.x >> 6), lane = threadIdx.x & 63;
    float xv[16], h2[16], acc[16];
    const float rr = r2[t];
#pragma unroll
    for (int m = 0; m < 4; ++m) {
        const float4 v = *(const float4*)(x2 + (size_t)t * 1024 + lane * 16 + 4 * m);
        const float4 w = *(const float4*)(ln2_w + lane * 16 + 4 * m);
        xv[4 * m] = v.x; xv[4 * m + 1] = v.y; xv[4 * m + 2] = v.z; xv[4 * m + 3] = v.w;
        h2[4 * m] = v.x * rr * w.x; h2[4 * m + 1] = v.y * rr * w.y; h2[4 * m + 2] = v.z * rr * w.z; h2[4 * m + 3] = v.w * rr * w.w;
        acc[4 * m] = 0.f; acc[4 * m + 1] = 0.f; acc[4 * m + 2] = 0.f; acc[4 * m + 3] = 0.f;
    }
    const int id0 = sel_id[(size_t)t * 128 + lane], id1 = sel_id[(size_t)t * 128 + 64 + lane];
    const float gg0 = sel_g[(size_t)t * 128 + lane], gg1 = sel_g[(size_t)t * 128 + 64 + lane];
    for (int k0 = 0; k0 < 128; k0 += 8) {
        const int idv = (k0 < 64) ? id0 : id1;
        const float gv = (k0 < 64) ? gg0 : gg1;
        uint4 ur[8], vr[8];
        float gate[8];
#pragma unroll
        for (int j = 0; j < 8; ++j) {
            const int id = __builtin_amdgcn_readlane(idv, (k0 & 63) + j);
            gate[j] = __uint_as_float(__builtin_amdgcn_readlane(__float_as_uint(gv), (k0 & 63) + j));
            ur[j] = *(const uint4*)(u8 + (size_t)id * 1024 + lane * 16);
            vr[j] = *(const uint4*)(v8 + (size_t)id * 1024 + lane * 16);
        }
#pragma unroll
        for (int j = 0; j < 8; ++j) {
            const float d = wave_sum(dot16_fp8(ur[j], h2)) * (1.f / U_SCALE);
            const float c = gate[j] * 0.5f * d * (1.f + erff(d * 0.70710678118654752f)) * (1.f / V_SCALE);
            axpy16_fp8(vr[j], c, acc);
        }
    }
    float ss = 0.f;
#pragma unroll
    for (int m = 0; m < 16; ++m) { acc[m] += xv[m]; ss += acc[m] * acc[m]; }
    ss = wave_sum(ss);
    const float rs = rsqrtf(ss * (1.f / 1024.f) + EPS);
#pragma unroll
    for (int m = 0; m < 4; ++m) {
        const float4 w = *(const float4*)(lnf_w + lane * 16 + 4 * m);
        *(float4*)(out + (size_t)t * 1024 + lane * 16 + 4 * m) = make_float4(acc[4 * m] * rs * w.x, acc[4 * m + 1] * rs * w.y, acc[4 * m + 2] * rs * w.z, acc[4 * m + 3] * rs * w.w);
    }
}

struct Params {
    const float* in[15];
    float* out;
    unsigned char* ws;
};
constexpr size_t MiB = 1024 * 1024;
constexpr size_t OFF_WIN = 0;
constexpr size_t OFF_WOUT = OFF_WIN + (size_t)NPROJ * 1024 * 2;
constexpr size_t OFF_WQ = OFF_WOUT + (size_t)1024 * 1024 * 2;
constexpr size_t OFF_KEYS = OFF_WQ + (size_t)2048 * 1024 * 2;
constexpr size_t OFF_R1 = OFF_KEYS + (size_t)16 * 128 * 128 * 2;
constexpr size_t OFF_R2 = OFF_R1 + 65536;
constexpr size_t OFF_GDEC = OFF_R2 + 65536;
constexpr size_t OFF_BETA = OFF_GDEC + 262144;
constexpr size_t OFF_GCB = OFF_BETA + 262144;
constexpr size_t OFF_C = ((OFF_GCB + 262144 + MiB - 1) / MiB) * MiB;
constexpr size_t OFF_D = OFF_C + 32 * MiB;
constexpr size_t OFF_E = OFF_D + 112 * MiB;
constexpr size_t WS_END = OFF_E + 64 * MiB;
constexpr int SMEM_BYTES = 2 * 2 * 128 * GLD * 2;

#define GRID_LOOP(b, n) for (int b = blockIdx.x; b < (n); b += gridDim.x)

__global__ __launch_bounds__(256) void mega(Params p) {
    cg::grid_group grid = cg::this_grid();
    __shared__ __attribute__((aligned(16))) unsigned char smem[SMEM_BYTES];
    const float* x = p.in[0]; const float* ln1_w = p.in[1]; const float* w_in = p.in[2]; const float* ret_norm_w = p.in[3];
    const float* conv_w = p.in[4]; const float* A_log = p.in[5]; const float* dt_bias = p.in[6]; const float* gdn_norm_w = p.in[7];
    const float* w_out = p.in[8]; const float* ln2_w = p.in[9]; const float* peer_wq = p.in[10]; const float* peer_keys = p.in[11];
    const float* peer_u = p.in[12]; const float* peer_v = p.in[13]; const float* lnf_w = p.in[14];
    float* out = p.out; unsigned char* ws = p.ws;
    bf16_t* WinT = (bf16_t*)(ws + OFF_WIN); bf16_t* WoutT = (bf16_t*)(ws + OFF_WOUT); bf16_t* WqT = (bf16_t*)(ws + OFF_WQ); bf16_t* keysb = (bf16_t*)(ws + OFF_KEYS);
    float* r1 = (float*)(ws + OFF_R1); float* r2 = (float*)(ws + OFF_R2); float* gdec = (float*)(ws + OFF_GDEC); float* beta = (float*)(ws + OFF_BETA);
    bf16_t* xb = (bf16_t*)(ws + OFF_C); bf16_t* x2b = xb;
    bf16_t* projb = (bf16_t*)(ws + OFF_D); bf16_t* qp = projb;
    unsigned* top1 = (unsigned*)(ws + OFF_D + 64 * MiB); int* sel_id = (int*)(ws + OFF_D + 80 * MiB); float* sel_g = (float*)(ws + OFF_D + 88 * MiB);
    bf16_t* UT = (bf16_t*)(ws + OFF_E); bf16_t* mixed = UT; bf16_t* Wm = (bf16_t*)(ws + OFF_E + 16 * MiB); bf16_t* KstT = (bf16_t*)(ws + OFF_E + 32 * MiB);
    bf16_t* kn = (bf16_t*)(ws + OFF_E + 48 * MiB);
    unsigned char* u8 = ws + OFF_E + 32 * MiB; unsigned char* v8 = ws + OFF_E + 48 * MiB;
    bf16_t* VnT = (bf16_t*)(ws + OFF_C); bf16_t* Sst = (bf16_t*)(ws + OFF_C + 16 * MiB);
    float* gcb = (float*)(ws + OFF_GCB);
    float* kvT = out; bf16_t* Srt = (bf16_t*)((unsigned char*)out + 16 * MiB);
    bf16_t* rqr = (bf16_t*)((unsigned char*)out + 24 * MiB); bf16_t* rkr = (bf16_t*)((unsigned char*)out + 32 * MiB); bf16_t* VTg = (bf16_t*)((unsigned char*)out + 40 * MiB);

    GRID_LOOP(b, T_ / 4) k_prep_x(b, x, ln1_w, w_in, A_log, dt_bias, xb, r1, gdec, beta);
    GRID_LOOP(b, (NPROJ / 32) * 32) k_transpose(b % (NPROJ / 32), b / (NPROJ / 32), (float(*)[33])smem, w_in, LDWIN, ln1_w, WinT, 1024);
    GRID_LOOP(b, 32 * 32) k_transpose(b % 32, b / 32, (float(*)[33])smem, w_out, 1024, nullptr, WoutT, 1024);
    GRID_LOOP(b, 64 * 32) k_transpose(b % 64, b / 64, (float(*)[33])smem, peer_wq, 2048, ln2_w, WqT, 1024);
    GRID_LOOP(b, (16 * 128 * 128 / 4) / 256) k_convert(b, peer_keys, keysb, 16 * 128 * 128 / 4);
    grid.sync();
    GRID_LOOP(b, (T_ / 128) * (NPROJ / 128)) k_gemm<0>(b, smem, xb, 1024, WinT, 1024, 1024, projb, NPROJ, r1, NPROJ / 128);
    grid.sync();
    GRID_LOOP(b, 1024) {
        if (b < 512) gdn_phaseA(b, smem, projb, conv_w, gdec, beta, UT, Wm, KstT, kn, gcb);
        else ret_phaseA(b - 512, smem, projb, rqr, rkr, VTg, kvT);
    }
    grid.sync();
    if (blockIdx.x < 16) gdn_scan(blockIdx.x, smem, UT, Wm, KstT, gcb, VnT, Sst);
    else if (blockIdx.x < 144) ret_scan((blockIdx.x - 16) * 256 + threadIdx.x, kvT, Srt);
    grid.sync();
    GRID_LOOP(b, 1024) {
        if (b < 512) gdn_phaseC(b, smem, projb, conv_w, kn, gcb, VnT, Sst, gdn_norm_w, mixed);
        else ret_phaseC(b - 512, smem, projb, rqr, rkr, VTg, Srt, ret_norm_w, mixed);
    }
    grid.sync();
    GRID_LOOP(b, (T_ / 128) * 8) k_gemm<1>(b, smem, mixed, 1024, WoutT, 1024, 1024, out, 1024, x, 8);
    grid.sync();
    GRID_LOOP(b, T_ / 4) k_rownorm2(b, out, x2b, r2);
    for (int g = blockIdx.x * 256 + threadIdx.x; g < 16384 * 64; g += gridDim.x * 256) { k_tab8(g, peer_u, u8, U_SCALE); k_tab8(g, peer_v, v8, V_SCALE); }
    grid.sync();
    GRID_LOOP(b, (T_ / 128) * 16) k_gemm<0>(b, smem, x2b, 1024, WqT, 1024, 1024, qp, 2048, r2, 16);
    grid.sync();
    GRID_LOOP(b, (T_ / 128) * 16) k_scores_topk(b, smem, qp, keysb, top1);
    grid.sync();
    GRID_LOOP(b, T_ * 8 / 256) k_cand(b, top1, sel_id, sel_g);
    grid.sync();
    GRID_LOOP(b, T_ / 4) k_peer8(b, out, r2, ln2_w, sel_id, sel_g, u8, v8, lnf_w, out);
}

extern "C" void kernel_launch(void* const* d_in, const int* in_sizes, int n_in, void* d_out, int out_size, void* d_ws, size_t ws_size, hipStream_t stream) {
    static int grid_blocks = 0;
    if (!grid_blocks) {
        int dev = 0, cus = 0, per_cu = 0;
        hipGetDevice(&dev);
        hipDeviceGetAttribute(&cus, hipDeviceAttributeMultiprocessorCount, dev);
        hipOccupancyMaxActiveBlocksPerMultiprocessor(&per_cu, mega, 256, 0);
        if (per_cu > 2) per_cu = 2;
        if (per_cu < 1) per_cu = 1;
        grid_blocks = cus * per_cu;
    }
    if (n_in < 15 || ws_size < WS_END) { fprintf(stderr, "kernel_launch: unexpected inputs / workspace (%d inputs, %zu bytes)\n", n_in, ws_size); return; }
    Params p{};
    for (int i = 0; i < 15; ++i) p.in[i] = (const float*)d_in[i];
    p.out = (float*)d_out; p.ws = (unsigned char*)d_ws;
    void* args[] = {&p};
    hipError_t e = hipLaunchCooperativeKernel((const void*)mega, dim3(grid_blocks), dim3(256), args, 0, stream);
    if (e != hipSuccess) fprintf(stderr, "cooperative launch failed: %s (grid %d)\n", hipGetErrorString(e), grid_blocks);
}
```

```cpp
#include <hip/hip_runtime.h>
#include <hip/hip_cooperative_groups.h>
#include <stdint.h>
#include <cstdio>
#include <utility>
namespace cg = cooperative_groups;

typedef unsigned short bf16_t;
typedef __attribute__((ext_vector_type(8))) short bf16x8;
typedef __attribute__((ext_vector_type(4))) float f32x4;

constexpr int T_ = 16384;
constexpr int NPROJ = 3584;
constexpr int LDWIN = 3592;
constexpr float EPS = 1e-6f;

constexpr int C_RQ = 0, C_RK = 256, C_RV = 512, C_RG = 1024, C_GQ = 1536, C_GK = 2048, C_GV = 2560, C_GZ = 3072;

__constant__ double INVREV[32] = {0.15915494309189535, 0.11934937021124886, 0.08949940160889101, 0.06711508300522726, 0.050329212104487035, 0.03774158471741977, 0.0283021958306234, 0.02122365276477766, 0.015915494309189534, 0.011934937021124886, 0.0089499401608891, 0.006711508300522725, 0.005032921210448704, 0.003774158471741977, 0.00283021958306234, 0.002122365276477766, 0.0015915494309189536, 0.0011934937021124887, 0.0008949940160889102, 0.0006711508300522725, 0.0005032921210448703, 0.0003774158471741977, 0.00028302195830623395, 0.00021223652764777658, 0.00015915494309189535, 0.00011934937021124886, 8.9499401608891e-05, 6.711508300522725e-05, 5.0329212104487035e-05, 3.774158471741978e-05, 2.83021958306234e-05, 2.122365276477766e-05};

__device__ __forceinline__ bf16_t f2bf(float f) {
    unsigned u = __float_as_uint(f);
    u += 0x7fffu + ((u >> 16) & 1u);
    return (bf16_t)(u >> 16);
}
__device__ __forceinline__ float bf2f(bf16_t h) { return __uint_as_float(((unsigned)h) << 16); }
__device__ __forceinline__ float wave_sum(float v) {
#pragma unroll
    for (int o = 32; o > 0; o >>= 1) v += __shfl_xor(v, o);
    return v;
}
__device__ __forceinline__ float silu(float x) { return x / (1.f + __expf(-x)); }
__device__ __forceinline__ unsigned fkey(float f) { unsigned u = __float_as_uint(f); return (u & 0x80000000u) ? ~u : (u | 0x80000000u); }
__device__ __forceinline__ float keyf(unsigned k) { return __uint_as_float((k & 0x80000000u) ? (k & 0x7fffffffu) : ~k); }

__device__ __forceinline__ void k_prep_x(int bid, const float* __restrict__ x, const float* __restrict__ ln1_w, const float* __restrict__ w_in,
                                                const float* __restrict__ A_log, const float* __restrict__ dt_bias,
                                                bf16_t* __restrict__ xb, float* __restrict__ r1, float* __restrict__ gdec, float* __restrict__ beta) {
    const int wave = threadIdx.x >> 6, lane = threadIdx.x & 63;
    const int row = bid * 4 + wave;
    const float* xr = x + (size_t)row * 1024;
    float ss = 0.f;
    float g0 = 0, g1 = 0, g2 = 0, g3 = 0, g4 = 0, g5 = 0, g6 = 0, g7 = 0;
#pragma unroll
    for (int j = 0; j < 4; ++j) {
        const int c = j * 256 + lane * 4;
        const float4 v = *(const float4*)(xr + c);
        const float4 w = *(const float4*)(ln1_w + c);
        ss += v.x * v.x + v.y * v.y + v.z * v.z + v.w * v.w;
        ushort4 o; o.x = f2bf(v.x); o.y = f2bf(v.y); o.z = f2bf(v.z); o.w = f2bf(v.w);
        *(ushort4*)(xb + (size_t)row * 1024 + c) = o;
        const float xs[4] = {v.x * w.x, v.y * w.y, v.z * w.z, v.w * w.w};
#pragma unroll
        for (int e = 0; e < 4; ++e) {
            const float* wp = w_in + (size_t)(c + e) * LDWIN + NPROJ;
            const float4 a = *(const float4*)wp; const float4 b = *(const float4*)(wp + 4);
            g0 += xs[e] * a.x; g1 += xs[e] * a.y; g2 += xs[e] * a.z; g3 += xs[e] * a.w;
            g4 += xs[e] * b.x; g5 += xs[e] * b.y; g6 += xs[e] * b.z; g7 += xs[e] * b.w;
        }
    }
    ss = wave_sum(ss);
    g0 = wave_sum(g0); g1 = wave_sum(g1); g2 = wave_sum(g2); g3 = wave_sum(g3);
    g4 = wave_sum(g4); g5 = wave_sum(g5); g6 = wave_sum(g6); g7 = wave_sum(g7);
    const float r = rsqrtf(ss * (1.f / 1024.f) + EPS);
    if (lane == 0) {
        r1[row] = r;
        const float ga[4] = {g0 * r, g1 * r, g2 * r, g3 * r};
        const float gb[4] = {g4 * r, g5 * r, g6 * r, g7 * r};
#pragma unroll
        for (int h = 0; h < 4; ++h) {
            const float xx = ga[h] + dt_bias[h];
            const float sp = xx > 20.f ? xx : log1pf(expf(xx));
            gdec[row * 4 + h] = -expf(A_log[h]) * sp;
            beta[row * 4 + h] = 1.f / (1.f + expf(-gb[h]));
        }
    }
}

__device__ __forceinline__ void k_transpose(int bidx, int bidy, float (*tile)[33], const float* __restrict__ src, int ld, const float* __restrict__ scale, bf16_t* __restrict__ dst, int K) {
    const int n0 = bidx * 32, k0 = bidy * 32;
    const int tx = threadIdx.x & 31, ty = threadIdx.x >> 5;
#pragma unroll
    for (int j = 0; j < 4; ++j) {
        const int k = k0 + ty + 8 * j;
        const float s = scale ? scale[k] : 1.f;
        tile[ty + 8 * j][tx] = src[(size_t)k * ld + n0 + tx] * s;
    }
    __syncthreads();
#pragma unroll
    for (int j = 0; j < 4; ++j) {
        const int n = n0 + ty + 8 * j;
        dst[(size_t)n * K + k0 + tx] = f2bf(tile[tx][ty + 8 * j]);
    }
    __syncthreads();
}

__device__ __forceinline__ void k_convert(int bid, const float* __restrict__ src, bf16_t* __restrict__ dst, int n4) {
    const int i = bid * 256 + threadIdx.x;
    if (i < n4) {
        const float4 v = ((const float4*)src)[i];
        ushort4 o; o.x = f2bf(v.x); o.y = f2bf(v.y); o.z = f2bf(v.z); o.w = f2bf(v.w);
        ((ushort4*)dst)[i] = o;
    }
}

constexpr int GLD = 72;
template <int EPI>
__device__ __forceinline__ void k_gemm(int bid, unsigned char* smem, const bf16_t* __restrict__ A, int lda, const bf16_t* __restrict__ Bt, int ldb, int K,
                                              void* __restrict__ Cv, int ldc, const float* __restrict__ aux, int ntn) {
    bf16_t (*As)[128][GLD] = (bf16_t(*)[128][GLD])smem;
    bf16_t (*Bs)[128][GLD] = (bf16_t(*)[128][GLD])(smem + 2 * 128 * GLD * 2);
    const int tid = threadIdx.x, lane = tid & 63, w = tid >> 6;
    const int wr = w >> 1, wc = w & 1, r = lane & 15, quad = lane >> 4;
    const int tm = bid / ntn, tn = bid % ntn;
    const int m0 = tm * 128, n0 = tn * 128;
    const bf16_t* Ag = A + (size_t)m0 * lda;
    const bf16_t* Bg = Bt + (size_t)n0 * ldb;
    f32x4 acc[4][4];
#pragma unroll
    for (int i = 0; i < 4; ++i)
#pragma unroll
        for (int j = 0; j < 4; ++j) acc[i][j] = (f32x4){0.f, 0.f, 0.f, 0.f};
    uint4 ra[4], rb[4];
    const int nk = K / 64;
#pragma unroll
    for (int j = 0; j < 4; ++j) {
        const int c = tid + 256 * j, row = c >> 3, cc = c & 7;
        ra[j] = *(const uint4*)(Ag + (size_t)row * lda + cc * 8);
        rb[j] = *(const uint4*)(Bg + (size_t)row * ldb + cc * 8);
    }
#pragma unroll
    for (int j = 0; j < 4; ++j) {
        const int c = tid + 256 * j, row = c >> 3, cc = c & 7;
        *(uint4*)&As[0][row][cc * 8] = ra[j];
        *(uint4*)&Bs[0][row][cc * 8] = rb[j];
    }
    __syncthreads();
    for (int kt = 0; kt < nk; ++kt) {
        const int buf = kt & 1;
        const int kn = (kt + 1 < nk) ? kt + 1 : kt;
#pragma unroll
        for (int j = 0; j < 4; ++j) {
            const int c = tid + 256 * j, row = c >> 3, cc = c & 7;
            ra[j] = *(const uint4*)(Ag + (size_t)row * lda + kn * 64 + cc * 8);
            rb[j] = *(const uint4*)(Bg + (size_t)row * ldb + kn * 64 + cc * 8);
        }
        const bf16_t (*Ab)[GLD] = As[buf];
        const bf16_t (*Bb)[GLD] = Bs[buf];
#pragma unroll
        for (int ks = 0; ks < 2; ++ks) {
            bf16x8 a[4], b[4];
#pragma unroll
            for (int i = 0; i < 4; ++i) a[i] = *(const bf16x8*)&Ab[wr * 64 + i * 16 + r][ks * 32 + quad * 8];
#pragma unroll
            for (int j = 0; j < 4; ++j) b[j] = *(const bf16x8*)&Bb[wc * 64 + j * 16 + r][ks * 32 + quad * 8];
#pragma unroll
            for (int i = 0; i < 4; ++i)
#pragma unroll
                for (int j = 0; j < 4; ++j) acc[i][j] = __builtin_amdgcn_mfma_f32_16x16x32_bf16(b[j], a[i], acc[i][j], 0, 0, 0);
        }
        bf16_t (*An)[GLD] = As[buf ^ 1];
        bf16_t (*Bn)[GLD] = Bs[buf ^ 1];
#pragma unroll
        for (int j = 0; j < 4; ++j) {
            const int c = tid + 256 * j, row = c >> 3, cc = c & 7;
            *(uint4*)&An[row][cc * 8] = ra[j];
            *(uint4*)&Bn[row][cc * 8] = rb[j];
        }
        __syncthreads();
    }
#pragma unroll
    for (int i = 0; i < 4; ++i) {
        const int row = m0 + wr * 64 + i * 16 + r;
        float rs = 1.f;
        if (EPI == 0) rs = aux[row];
#pragma unroll
        for (int j = 0; j < 4; ++j) {
            const int col = n0 + wc * 64 + j * 16 + quad * 4;
            if (EPI == 0) {
                ushort4 o; o.x = f2bf(acc[i][j][0] * rs); o.y = f2bf(acc[i][j][1] * rs); o.z = f2bf(acc[i][j][2] * rs); o.w = f2bf(acc[i][j][3] * rs);
                *(ushort4*)((bf16_t*)Cv + (size_t)row * ldc + col) = o;
            } else {
                const float4 xr = *(const float4*)(aux + (size_t)row * ldc + col);
                float4 o; o.x = xr.x + acc[i][j][0]; o.y = xr.y + acc[i][j][1]; o.z = xr.z + acc[i][j][2]; o.w = xr.w + acc[i][j][3];
                *(float4*)((float*)Cv + (size_t)row * ldc + col) = o;
            }
        }
    }
}

__device__ __forceinline__ void k_preproc(int bid, const bf16_t* __restrict__ projb, const float* __restrict__ conv_w,
                                                 bf16_t* __restrict__ rqr, bf16_t* __restrict__ rkr,
                                                 bf16_t* __restrict__ cq, bf16_t* __restrict__ ck, bf16_t* __restrict__ cv) {
    const int t = bid, tid = threadIdx.x;
    {
        const int which = tid >> 7, h = (tid >> 5) & 3, j = tid & 31;
        const bf16_t* p = projb + (size_t)t * NPROJ + which * 256 + h * 64;
        const float a = bf2f(p[j]), b = bf2f(p[j + 32]);
        double u = (double)t * INVREV[j];
        u -= rint(u);
        const float fr = (float)u;
        const float sn = __builtin_amdgcn_sinf(fr), cs = __builtin_amdgcn_cosf(fr);
        const float sc = which ? 0.125f : 1.f;
        bf16_t* o = (which ? rkr : rqr) + (size_t)t * 256 + h * 64;
        o[j] = f2bf((a * cs - b * sn) * sc);
        o[j + 32] = f2bf((a * sn + b * cs) * sc);
    }
    {
        const int h = tid >> 6, l = tid & 63;
        float vals[3][2];
#pragma unroll
        for (int part = 0; part < 3; ++part)
#pragma unroll
            for (int e = 0; e < 2; ++e) {
                const int c = part * 512 + h * 128 + 2 * l + e;
                float acc = 0.f;
#pragma unroll
                for (int j = 0; j < 4; ++j) {
                    const int tt = t - 3 + j;
                    if (tt >= 0) acc += conv_w[j * 1536 + c] * bf2f(projb[(size_t)tt * NPROJ + C_GQ + c]);
                }
                vals[part][e] = silu(acc);
            }
        const float sq = wave_sum(vals[0][0] * vals[0][0] + vals[0][1] * vals[0][1]);
        const float sk = wave_sum(vals[1][0] * vals[1][0] + vals[1][1] * vals[1][1]);
        const float rq = rsqrtf(sq + EPS), rk = rsqrtf(sk + EPS);
        const size_t o = (size_t)t * 512 + h * 128 + 2 * l;
        cq[o] = f2bf(vals[0][0] * rq); cq[o + 1] = f2bf(vals[0][1] * rq);
        ck[o] = f2bf(vals[1][0] * rk); ck[o + 1] = f2bf(vals[1][1] * rk);
        cv[o] = f2bf(vals[2][0]); cv[o + 1] = f2bf(vals[2][1]);
    }
}

__device__ __forceinline__ void k_recur_ret(int bid, const bf16_t* __restrict__ rqr, const bf16_t* __restrict__ rkr, const bf16_t* __restrict__ projb, float* __restrict__ o_r) {
    const int h = bid >> 7, e = bid & 127, lane = threadIdx.x & 63;
    const float gamma = 1.f - exp2f(-5.f - (float)h);
    float s = 0.f;
    const bf16_t* qp = rqr + h * 64 + lane;
    const bf16_t* kp = rkr + h * 64 + lane;
    const bf16_t* vp = projb + C_RV + h * 128 + e;
    for (int t0 = 0; t0 < T_; t0 += 8) {
        float k[8], q[8], v[8];
#pragma unroll
        for (int i = 0; i < 8; ++i) {
            k[i] = bf2f(kp[(size_t)(t0 + i) * 256]);
            q[i] = bf2f(qp[(size_t)(t0 + i) * 256]);
            v[i] = bf2f(vp[(size_t)(t0 + i) * NPROJ]);
        }
#pragma unroll
        for (int i = 0; i < 8; ++i) {
            s = gamma * s + k[i] * v[i];
            const float p = wave_sum(q[i] * s);
            if (lane == 0) o_r[(size_t)(t0 + i) * 512 + h * 128 + e] = p;
        }
    }
}

__device__ __forceinline__ void k_recur_gdn(int bid, const bf16_t* __restrict__ cq, const bf16_t* __restrict__ ck, const bf16_t* __restrict__ cv,
                                                  const float* __restrict__ gdec, const float* __restrict__ beta, float* __restrict__ o_g) {
    const int h = bid >> 7, e = bid & 127, lane = threadIdx.x & 63;
    float s0 = 0.f, s1 = 0.f;
    const bf16_t* qp = cq + h * 128 + 2 * lane;
    const bf16_t* kp = ck + h * 128 + 2 * lane;
    const bf16_t* vp = cv + h * 128 + e;
    for (int t0 = 0; t0 < T_; t0 += 8) {
        float k0[8], k1[8], q0[8], q1[8], v[8], a[8], b[8];
#pragma unroll
        for (int i = 0; i < 8; ++i) {
            const size_t t = t0 + i;
            k0[i] = bf2f(kp[t * 512]); k1[i] = bf2f(kp[t * 512 + 1]);
            q0[i] = bf2f(qp[t * 512]); q1[i] = bf2f(qp[t * 512 + 1]);
            v[i] = bf2f(vp[t * 512]);
            a[i] = __expf(gdec[t * 4 + h]);
            b[i] = beta[t * 4 + h];
        }
#pragma unroll
        for (int i = 0; i < 8; ++i) {
            const float ks = wave_sum(k0[i] * s0 + k1[i] * s1);
            const float coef = b[i] * (v[i] - a[i] * ks);
            s0 = a[i] * s0 + coef * k0[i];
            s1 = a[i] * s1 + coef * k1[i];
            const float o = wave_sum(q0[i] * s0 + q1[i] * s1) * 0.08838834764831845f;
            if (lane == 0) o_g[(size_t)(t0 + i) * 512 + h * 128 + e] = o;
        }
    }
}

__device__ __forceinline__ void k_mixnorm(int bid, const float* __restrict__ o_r, const float* __restrict__ o_g, const bf16_t* __restrict__ projb,
                                                 const float* __restrict__ ret_norm_w, const float* __restrict__ gdn_norm_w, bf16_t* __restrict__ mixed) {
    const int gw = bid * 4 + (threadIdx.x >> 6), l = threadIdx.x & 63;
    const int t = gw >> 3, g = gw & 7;
    if (g < 4) {
        const float2 o = *(const float2*)(o_r + (size_t)t * 512 + g * 128 + 2 * l);
        const float mu = wave_sum(o.x + o.y) * (1.f / 128.f);
        const float d0 = o.x - mu, d1 = o.y - mu;
        const float var = wave_sum(d0 * d0 + d1 * d1) * (1.f / 128.f);
        const float rs = rsqrtf(var + EPS);
        const bf16_t* gp = projb + (size_t)t * NPROJ + C_RG + g * 128 + 2 * l;
        const float y0 = d0 * rs * ret_norm_w[g * 128 + 2 * l] * silu(bf2f(gp[0]));
        const float y1 = d1 * rs * ret_norm_w[g * 128 + 2 * l + 1] * silu(bf2f(gp[1]));
        bf16_t* mp = mixed + (size_t)t * 1024 + g * 128 + 2 * l;
        mp[0] = f2bf(y0); mp[1] = f2bf(y1);
    } else {
        const int h = g - 4;
        const float2 o = *(const float2*)(o_g + (size_t)t * 512 + h * 128 + 2 * l);
        const float ms = wave_sum(o.x * o.x + o.y * o.y) * (1.f / 128.f);
        const float rs = rsqrtf(ms + EPS);
        const bf16_t* gp = projb + (size_t)t * NPROJ + C_GZ + h * 128 + 2 * l;
        const float y0 = o.x * rs * gdn_norm_w[2 * l] * silu(bf2f(gp[0]));
        const float y1 = o.y * rs * gdn_norm_w[2 * l + 1] * silu(bf2f(gp[1]));
        bf16_t* mp = mixed + (size_t)t * 1024 + 512 + h * 128 + 2 * l;
        mp[0] = f2bf(y0); mp[1] = f2bf(y1);
    }
}

__device__ __forceinline__ void k_rownorm2(int bid, const float* __restrict__ x2, bf16_t* __restrict__ x2b, float* __restrict__ r2) {
    const int row = bid * 4 + (threadIdx.x >> 6), lane = threadIdx.x & 63;
    float ss = 0.f;
#pragma unroll
    for (int j = 0; j < 4; ++j) {
        const int c = j * 256 + lane * 4;
        const float4 v = *(const float4*)(x2 + (size_t)row * 1024 + c);
        ss += v.x * v.x + v.y * v.y + v.z * v.z + v.w * v.w;
        ushort4 o; o.x = f2bf(v.x); o.y = f2bf(v.y); o.z = f2bf(v.z); o.w = f2bf(v.w);
        *(ushort4*)(x2b + (size_t)row * 1024 + c) = o;
    }
    ss = wave_sum(ss);
    if (lane == 0) r2[row] = rsqrtf(ss * (1.f / 1024.f) + EPS);
}

constexpr int SLD = 136;
__device__ __forceinline__ void k_scores_topk(int bid, unsigned char* smem, const bf16_t* __restrict__ qp, const bf16_t* __restrict__ keysb, unsigned* __restrict__ top1) {
    bf16_t (*As)[SLD] = (bf16_t(*)[SLD])smem;
    bf16_t (*Bs)[SLD] = (bf16_t(*)[SLD])(smem + 128 * SLD * 2);
    unsigned (*S)[129] = (unsigned(*)[129])smem;
    const int tid = threadIdx.x, lane = tid & 63, w = tid >> 6;
    const int wr = w >> 1, wc = w & 1, r = lane & 15, quad = lane >> 4;
    const int hp = bid & 15, t0 = (bid >> 4) * 128;
#pragma unroll
    for (int j = 0; j < 8; ++j) {
        const int c = tid + 256 * j, row = c >> 4, cc = c & 15;
        *(uint4*)&As[row][cc * 8] = *(const uint4*)(qp + (size_t)(t0 + row) * 2048 + hp * 128 + cc * 8);
        *(uint4*)&Bs[row][cc * 8] = *(const uint4*)(keysb + (size_t)hp * 16384 + row * 128 + cc * 8);
    }
    __syncthreads();
    f32x4 acc[4][4];
#pragma unroll
    for (int i = 0; i < 4; ++i)
#pragma unroll
        for (int j = 0; j < 4; ++j) acc[i][j] = (f32x4){0.f, 0.f, 0.f, 0.f};
#pragma unroll
    for (int ks = 0; ks < 4; ++ks) {
        bf16x8 a[4], b[4];
#pragma unroll
        for (int i = 0; i < 4; ++i) a[i] = *(const bf16x8*)&As[wr * 64 + i * 16 + r][ks * 32 + quad * 8];
#pragma unroll
        for (int j = 0; j < 4; ++j) b[j] = *(const bf16x8*)&Bs[wc * 64 + j * 16 + r][ks * 32 + quad * 8];
#pragma unroll
        for (int i = 0; i < 4; ++i)
#pragma unroll
            for (int j = 0; j < 4; ++j) acc[i][j] = __builtin_amdgcn_mfma_f32_16x16x32_bf16(b[j], a[i], acc[i][j], 0, 0, 0);
    }
    __syncthreads();
#pragma unroll
    for (int i = 0; i < 4; ++i)
#pragma unroll
        for (int j = 0; j < 4; ++j)
#pragma unroll
            for (int v = 0; v < 4; ++v) {
                const int row = wr * 64 + i * 16 + r, col = wc * 64 + j * 16 + quad * 4 + v;
                S[row][col] = (fkey(acc[i][j][v]) & ~0x7Fu) | (unsigned)col;
            }
    __syncthreads();
    if (tid < 128) {
        unsigned top[16];
#pragma unroll
        for (int i = 0; i < 16; ++i) top[i] = 0u;
        for (int c = 0; c < 128; ++c) {
            const unsigned v = S[tid][c];
            if (v > top[15]) {
                top[15] = v;
#pragma unroll
                for (int i = 15; i > 0; --i) {
                    const unsigned hi = max(top[i - 1], top[i]), lo = min(top[i - 1], top[i]);
                    top[i - 1] = hi; top[i] = lo;
                }
            }
        }
        unsigned* o = top1 + ((size_t)(t0 + tid) * 16 + hp) * 16;
#pragma unroll
        for (int i = 0; i < 4; ++i) *(uint4*)(o + 4 * i) = make_uint4(top[4 * i], top[4 * i + 1], top[4 * i + 2], top[4 * i + 3]);
    }
    __syncthreads();
}

__device__ __forceinline__ void k_cand(int bid, const unsigned* __restrict__ top1, int* __restrict__ sel_id, float* __restrict__ sel_g) {
    const int gid = bid * 256 + threadIdx.x;
    const int t = gid >> 3, h = gid & 7;
    const unsigned* p0 = top1 + ((size_t)t * 16 + h * 2) * 16;
    const unsigned* p1 = p0 + 16;
    float s1[16], s2[16];
#pragma unroll
    for (int i = 0; i < 4; ++i) {
        const uint4 a = *(const uint4*)(p0 + 4 * i), b = *(const uint4*)(p1 + 4 * i);
        s1[4 * i] = keyf(a.x & ~0x7Fu); s1[4 * i + 1] = keyf(a.y & ~0x7Fu); s1[4 * i + 2] = keyf(a.z & ~0x7Fu); s1[4 * i + 3] = keyf(a.w & ~0x7Fu);
        s2[4 * i] = keyf(b.x & ~0x7Fu); s2[4 * i + 1] = keyf(b.y & ~0x7Fu); s2[4 * i + 2] = keyf(b.z & ~0x7Fu); s2[4 * i + 3] = keyf(b.w & ~0x7Fu);
    }
    unsigned top[16];
#pragma unroll
    for (int i = 0; i < 16; ++i) top[i] = 0u;
#pragma unroll
    for (int a = 0; a < 16; ++a)
#pragma unroll
        for (int b = 0; b < 16; ++b)
            if ((a + 1) * (b + 1) <= 16) {
                const unsigned v = (fkey(s1[a] + s2[b]) & ~0xFFu) | (unsigned)(a * 16 + b);
                if (v > top[15]) {
                    top[15] = v;
#pragma unroll
                    for (int i = 15; i > 0; --i) {
                        const unsigned hi = max(top[i - 1], top[i]), lo = min(top[i - 1], top[i]);
                        top[i - 1] = hi; top[i] = lo;
                    }
                }
            }
    float ex[16], sum = 0.f;
    const float m = keyf(top[0] & ~0xFFu);
#pragma unroll
    for (int i = 0; i < 16; ++i) { ex[i] = __expf(keyf(top[i] & ~0xFFu) - m); sum += ex[i]; }
    const float inv = 1.f / sum;
#pragma unroll
    for (int i = 0; i < 16; ++i) {
        const int ab = top[i] & 0xFF;
        const int i1 = p0[ab >> 4] & 0x7F, i2 = p1[ab & 15] & 0x7F;
        sel_id[(size_t)t * 128 + h * 16 + i] = i1 * 128 + i2;
        sel_g[(size_t)t * 128 + h * 16 + i] = ex[i] * inv;
    }
}

__device__ __forceinline__ void k_peer(int bid, const float* x2, const float* __restrict__ r2, const float* __restrict__ ln2_w,
                                              const int* __restrict__ sel_id, const float* __restrict__ sel_g,
                                              const float* __restrict__ peer_u, const float* __restrict__ peer_v, const float* __restrict__ lnf_w,
                                              float* out) {
    const int t = bid * 4 + (threadIdx.x >> 6), lane = threadIdx.x & 63;
    float4 xv[4], h2[4], acc[4];
    const float rr = r2[t];
#pragma unroll
    for (int j = 0; j < 4; ++j) {
        const int c = j * 256 + lane * 4;
        xv[j] = *(const float4*)(x2 + (size_t)t * 1024 + c);
        const float4 w = *(const float4*)(ln2_w + c);
        h2[j] = make_float4(xv[j].x * rr * w.x, xv[j].y * rr * w.y, xv[j].z * rr * w.z, xv[j].w * rr * w.w);
        acc[j] = make_float4(0.f, 0.f, 0.f, 0.f);
    }
    const int id0 = sel_id[(size_t)t * 128 + lane], id1 = sel_id[(size_t)t * 128 + 64 + lane];
    const float gg0 = sel_g[(size_t)t * 128 + lane], gg1 = sel_g[(size_t)t * 128 + 64 + lane];
    for (int half = 0; half < 2; ++half) {
        const int idv = half ? id1 : id0;
        const float gv = half ? gg1 : gg0;
#pragma unroll 4
        for (int k = 0; k < 64; ++k) {
            const int id = __builtin_amdgcn_readlane(idv, k);
            const float gate = __uint_as_float(__builtin_amdgcn_readlane(__float_as_uint(gv), k));
            const float* ur = peer_u + (size_t)id * 1024 + lane * 4;
            float d = 0.f;
#pragma unroll
            for (int j = 0; j < 4; ++j) {
                const float4 u4 = *(const float4*)(ur + 256 * j);
                d += u4.x * h2[j].x + u4.y * h2[j].y + u4.z * h2[j].z + u4.w * h2[j].w;
            }
            d = wave_sum(d);
            const float c = gate * 0.5f * d * (1.f + erff(d * 0.70710678118654752f));
            const float* vr = peer_v + (size_t)id * 1024 + lane * 4;
#pragma unroll
            for (int j = 0; j < 4; ++j) {
                const float4 v4 = *(const float4*)(vr + 256 * j);
                acc[j].x += c * v4.x; acc[j].y += c * v4.y; acc[j].z += c * v4.z; acc[j].w += c * v4.w;
            }
        }
    }
    float ss = 0.f;
#pragma unroll
    for (int j = 0; j < 4; ++j) {
        acc[j].x += xv[j].x; acc[j].y += xv[j].y; acc[j].z += xv[j].z; acc[j].w += xv[j].w;
        ss += acc[j].x * acc[j].x + acc[j].y * acc[j].y + acc[j].z * acc[j].z + acc[j].w * acc[j].w;
    }
    ss = wave_sum(ss);
    const float rs = rsqrtf(ss * (1.f / 1024.f) + EPS);
#pragma unroll
    for (int j = 0; j < 4; ++j) {
        const int c = j * 256 + lane * 4;
        const float4 w = *(const float4*)(lnf_w + c);
        *(float4*)(out + (size_t)t * 1024 + c) = make_float4(acc[j].x * rs * w.x, acc[j].y * rs * w.y, acc[j].z * rs * w.z, acc[j].w * rs * w.w);
    }
}

constexpr int LDT = 136;
constexpr float QSCALE = 0.08838834764831845f;
constexpr size_t CH = 128 * 128;

__device__ __forceinline__ f32x4 mfma16(bf16x8 a, bf16x8 b, f32x4 c) { return __builtin_amdgcn_mfma_f32_16x16x32_bf16(a, b, c, 0, 0, 0); }
__device__ __forceinline__ uint2 pack4(float a, float b, float c, float d) {
    uint2 r; r.x = (unsigned)f2bf(a) | ((unsigned)f2bf(b) << 16); r.y = (unsigned)f2bf(c) | ((unsigned)f2bf(d) << 16); return r;
}
__device__ __forceinline__ int lrow(int i) {
    const int m = i - 1, a = m >> 2, b = m & 3;
    return i <= 0 ? 0 : 8 * a * (a + 1) + 4 * b * (a + 1);
}
constexpr int LROW_TOTAL = 8320;

__device__ __forceinline__ void conv_norm_rows(int tid, const bf16_t* __restrict__ projb, int t0, int colbase, const float* cw, bf16_t (*tile)[LDT], bf16_t* gout) {
    const int i = tid >> 1, hf = tid & 1;
    float vals[64];
    float ss = 0.f;
#pragma unroll
    for (int g = 0; g < 8; ++g) {
        float acc[8];
#pragma unroll
        for (int k = 0; k < 8; ++k) acc[k] = 0.f;
#pragma unroll
        for (int j = 0; j < 4; ++j) {
            const int tt = t0 + i - 3 + j;
            if (tt >= 0) {
                const uint4 raw = *(const uint4*)(projb + (size_t)tt * NPROJ + colbase + hf * 64 + g * 8);
                const float4 w0 = *(const float4*)(cw + j * 128 + hf * 64 + g * 8), w1 = *(const float4*)(cw + j * 128 + hf * 64 + g * 8 + 4);
                acc[0] += w0.x * __uint_as_float(raw.x << 16); acc[1] += w0.y * __uint_as_float(raw.x & 0xffff0000u);
                acc[2] += w0.z * __uint_as_float(raw.y << 16); acc[3] += w0.w * __uint_as_float(raw.y & 0xffff0000u);
                acc[4] += w1.x * __uint_as_float(raw.z << 16); acc[5] += w1.y * __uint_as_float(raw.z & 0xffff0000u);
                acc[6] += w1.z * __uint_as_float(raw.w << 16); acc[7] += w1.w * __uint_as_float(raw.w & 0xffff0000u);
            }
        }
#pragma unroll
        for (int k = 0; k < 8; ++k) { const float s = silu(acc[k]); vals[g * 8 + k] = s; ss += s * s; }
        if (g & 1) asm volatile("" ::: "memory");
    }
    ss += __shfl_xor(ss, 1);
    const float rs = rsqrtf(ss + EPS);
#pragma unroll
    for (int g = 0; g < 8; ++g) {
        const uint2 p0 = pack4(vals[g * 8] * rs, vals[g * 8 + 1] * rs, vals[g * 8 + 2] * rs, vals[g * 8 + 3] * rs);
        const uint2 p1 = pack4(vals[g * 8 + 4] * rs, vals[g * 8 + 5] * rs, vals[g * 8 + 6] * rs, vals[g * 8 + 7] * rs);
        const uint4 o = make_uint4(p0.x, p0.y, p1.x, p1.y);
        *(uint4*)&tile[i][hf * 64 + g * 8] = o;
        if (gout) *(uint4*)(gout + (size_t)(t0 + i) * 512 + hf * 64 + g * 8) = o;
    }
}

struct SolveCtx { const bf16_t* vp; const float* bts; const float* gcs; const bf16_t* kt; const float* Lp; float w0, w1, w2, w3; int t0, ecol; bool isV; };
template <int I>
__device__ __forceinline__ void solve_row(float (&x)[128], float (&pf)[8], float& r0, float& r1, float& r2, int& zo, const SolveCtx& c) {
    if (I > 0) asm volatile("" : "+v"(zo) : "v"(x[I > 0 ? I - 1 : 0]));
    float s;
    if (c.isV) {
        const float r3 = pf[I & 7];
        if (I + 8 < 128) pf[I & 7] = bf2f((c.vp + zo)[(size_t)(c.t0 + I + 8) * NPROJ]);
        s = (c.bts + zo)[I] * silu(c.w0 * r0 + c.w1 * r1 + c.w2 * r2 + c.w3 * r3);
        r0 = r1; r1 = r2; r2 = r3;
    } else {
        s = (c.bts + zo)[I] * __expf((c.gcs + zo)[I]) * bf2f((c.kt + zo)[I * LDT + c.ecol]);
    }
#pragma unroll
    for (int g = 0; g < (I + 3) / 4; ++g) {
        if (g && (g & 7) == 0) asm volatile("" : "+v"(zo) : "v"(s));
        const float* Lr = c.Lp + zo;
        const float4 l = *(const float4*)&Lr[lrow(I) + 4 * g];
        if (4 * g + 0 < I) s -= l.x * x[4 * g + 0];
        if (4 * g + 1 < I) s -= l.y * x[4 * g + 1];
        if (4 * g + 2 < I) s -= l.z * x[4 * g + 2];
        if (4 * g + 3 < I) s -= l.w * x[4 * g + 3];
    }
    x[I] = s;
}
template <int... Is>
__device__ __forceinline__ void solve_rows(std::integer_sequence<int, Is...>, float (&x)[128], float (&pf)[8], float& r0, float& r1, float& r2, int& zo, const SolveCtx& c) {
    (solve_row<Is>(x, pf, r0, r1, r2, zo, c), ...);
}

__device__ __forceinline__ void gdn_phaseA(int item, unsigned char* smem, const bf16_t* __restrict__ projb, const float* __restrict__ conv_w,
                                           const float* __restrict__ gdec, const float* __restrict__ beta,
                                           bf16_t* __restrict__ UT, bf16_t* __restrict__ Wm, bf16_t* __restrict__ KstT, bf16_t* __restrict__ kn, float* __restrict__ gcb) {
    const int h = item & 3, n = item >> 2, t0 = n * 128;
    int tid_ = threadIdx.x; asm volatile("" : "+v"(tid_));
    const int tid = tid_, lane = tid & 63, w = tid >> 6;
    { int zoff = 0; asm volatile("" : "+s"(zoff)); smem += zoff; }
    float* gs = (float*)smem;
    float* gcs = gs + 128;
    float* bts = gcs + 128;
    float* cw = bts + 128;
    float* Lp = cw + 512;
    bf16_t (*Kt)[LDT] = (bf16_t(*)[LDT])(smem + 3584 + LROW_TOTAL * 4);
    if (tid < 128) { gs[tid] = gdec[(size_t)(t0 + tid) * 4 + h]; bts[tid] = beta[(size_t)(t0 + tid) * 4 + h]; }
    for (int u = tid; u < 512; u += 256) cw[u] = conv_w[(u >> 7) * 1536 + 512 + h * 128 + (u & 127)];
    __syncthreads();
    if (tid < 128) {
        float s = 0.f;
        for (int j = 0; j <= tid; ++j) s += gs[j];
        gcs[tid] = s;
        gcb[(size_t)(h * 128 + n) * 128 + tid] = s;
    }
    conv_norm_rows(tid, projb, t0, C_GK + h * 128, cw, Kt, kn + h * 128);
    __syncthreads();
    {
        const int wr = w >> 1, wc = w & 1, r = lane & 15, quad = lane >> 4;
        if (!(wr == 0 && wc == 1)) {
            f32x4 acc[4][4];
#pragma unroll
            for (int i = 0; i < 4; ++i)
#pragma unroll
                for (int j = 0; j < 4; ++j) acc[i][j] = (f32x4){0.f, 0.f, 0.f, 0.f};
#pragma unroll
            for (int ks = 0; ks < 4; ++ks) {
                bf16x8 a[4], b[4];
#pragma unroll
                for (int i = 0; i < 4; ++i) a[i] = *(const bf16x8*)&Kt[wr * 64 + i * 16 + r][ks * 32 + quad * 8];
#pragma unroll
                for (int j = 0; j < 4; ++j) b[j] = *(const bf16x8*)&Kt[wc * 64 + j * 16 + r][ks * 32 + quad * 8];
#pragma unroll
                for (int i = 0; i < 4; ++i)
#pragma unroll
                    for (int j = 0; j < 4; ++j) acc[i][j] = mfma16(b[j], a[i], acc[i][j]);
            }
#pragma unroll
            for (int i = 0; i < 4; ++i) {
                const int row = wr * 64 + i * 16 + r;
                const float bi = bts[row], gi = gcs[row];
                const int rs = lrow(row);
#pragma unroll
                for (int j = 0; j < 4; ++j) {
                    const int c0 = wc * 64 + j * 16 + quad * 4;
                    if (c0 < row) {
                        float4 o;
                        o.x = (c0 + 0 < row) ? bi * acc[i][j][0] * __expf(gi - gcs[c0 + 0]) : 0.f;
                        o.y = (c0 + 1 < row) ? bi * acc[i][j][1] * __expf(gi - gcs[c0 + 1]) : 0.f;
                        o.z = (c0 + 2 < row) ? bi * acc[i][j][2] * __expf(gi - gcs[c0 + 2]) : 0.f;
                        o.w = (c0 + 3 < row) ? bi * acc[i][j][3] * __expf(gi - gcs[c0 + 3]) : 0.f;
                        *(float4*)&Lp[rs + c0] = o;
                    }
                }
            }
        }
    }
    __syncthreads();
    float x[128];
    const size_t cbase = (size_t)(h * 128 + n) * CH;
    const bool isV = tid < 128;
    const int ecol = tid & 127;
    const bf16_t* vp = projb + C_GV + h * 128 + ecol;
    float w0 = 0.f, w1 = 0.f, w2 = 0.f, w3 = 0.f, r0 = 0.f, r1 = 0.f, r2 = 0.f;
    float pf[8];
#pragma unroll
    for (int k = 0; k < 8; ++k) pf[k] = 0.f;
    if (isV) {
        w0 = conv_w[0 * 1536 + 1024 + h * 128 + ecol]; w1 = conv_w[1 * 1536 + 1024 + h * 128 + ecol];
        w2 = conv_w[2 * 1536 + 1024 + h * 128 + ecol]; w3 = conv_w[3 * 1536 + 1024 + h * 128 + ecol];
        r0 = (t0 >= 3) ? bf2f(vp[(size_t)(t0 - 3) * NPROJ]) : 0.f;
        r1 = (t0 >= 2) ? bf2f(vp[(size_t)(t0 - 2) * NPROJ]) : 0.f;
        r2 = (t0 >= 1) ? bf2f(vp[(size_t)(t0 - 1) * NPROJ]) : 0.f;
#pragma unroll
        for (int k = 0; k < 8; ++k) pf[k] = bf2f(vp[(size_t)(t0 + k) * NPROJ]);
    }
    int zo = 0;
    {
        SolveCtx c; c.vp = vp; c.bts = bts; c.gcs = gcs; c.kt = &Kt[0][0]; c.Lp = Lp; c.w0 = w0; c.w1 = w1; c.w2 = w2; c.w3 = w3; c.t0 = t0; c.ecol = ecol; c.isV = isV;
        solve_rows(std::make_integer_sequence<int, 128>{}, x, pf, r0, r1, r2, zo, c);
    }
    if (tid < 128) {
        bf16_t* up = UT + cbase + (size_t)tid * 128;
#pragma unroll
        for (int g = 0; g < 16; ++g) {
            const uint2 p0 = pack4(x[8 * g], x[8 * g + 1], x[8 * g + 2], x[8 * g + 3]), p1 = pack4(x[8 * g + 4], x[8 * g + 5], x[8 * g + 6], x[8 * g + 7]);
            *(uint4*)(up + 8 * g) = make_uint4(p0.x, p0.y, p1.x, p1.y);
        }
    } else {
        const int d = tid - 128;
        const float gl = gcs[127];
        bf16_t* kp = KstT + cbase + (size_t)d * 128;
#pragma unroll
        for (int g = 0; g < 16; ++g) {
            float kv[8];
#pragma unroll
            for (int k = 0; k < 8; ++k) kv[k] = bf2f(Kt[8 * g + k][d]) * __expf(gl - gcs[8 * g + k]);
            const uint2 p0 = pack4(kv[0], kv[1], kv[2], kv[3]), p1 = pack4(kv[4], kv[5], kv[6], kv[7]);
            *(uint4*)(kp + 8 * g) = make_uint4(p0.x, p0.y, p1.x, p1.y);
        }
    }
    __syncthreads();
    if (tid >= 128) {
        const int d = tid - 128;
#pragma unroll
        for (int i = 0; i < 128; ++i) Kt[i][d] = f2bf(x[i]);
    }
    __syncthreads();
#pragma unroll
    for (int j = 0; j < 8; ++j) {
        const int c = tid + 256 * j, row = c >> 4, cc = c & 15;
        *(uint4*)(Wm + cbase + (size_t)row * 128 + cc * 8) = *(const uint4*)&Kt[row][cc * 8];
    }
    __syncthreads();
}

struct ScanFrags { bf16x8 aw[2][4]; bf16x8 ak[2][4]; uint2 u[2][2]; float dec; };
__device__ __forceinline__ void scan_load(ScanFrags& f, int h, int n, int c, int w, int r, int quad,
                                          const bf16_t* __restrict__ UT, const bf16_t* __restrict__ Wm, const bf16_t* __restrict__ KstT, const float* __restrict__ gcb) {
    const size_t cbase = (size_t)(h * 128 + n) * CH;
#pragma unroll
    for (int mt = 0; mt < 2; ++mt)
#pragma unroll
        for (int ks = 0; ks < 4; ++ks) {
            const size_t o = cbase + (size_t)(32 * w + 16 * mt + r) * 128 + ks * 32 + quad * 8;
            f.aw[mt][ks] = *(const bf16x8*)(Wm + o);
            f.ak[mt][ks] = *(const bf16x8*)(KstT + o);
        }
#pragma unroll
    for (int mt = 0; mt < 2; ++mt)
#pragma unroll
        for (int nt = 0; nt < 2; ++nt)
            f.u[mt][nt] = *(const uint2*)(UT + cbase + (size_t)(32 * c + 16 * nt + r) * 128 + 32 * w + 16 * mt + quad * 4);
    f.dec = __expf(gcb[(size_t)(h * 128 + n) * 128 + 127]);
}
__device__ __forceinline__ void scan_step(const ScanFrags& f, f32x4 (&s)[2][2], int h, int n, int c, int w, int r, int quad,
                                          bf16_t (*ST)[LDT], bf16_t (*VT)[LDT], bf16_t* __restrict__ VnT, bf16_t* __restrict__ Sst) {
    f32x4 xa[2][2];
#pragma unroll
    for (int mt = 0; mt < 2; ++mt)
#pragma unroll
        for (int nt = 0; nt < 2; ++nt) xa[mt][nt] = (f32x4){0.f, 0.f, 0.f, 0.f};
#pragma unroll
    for (int ks = 0; ks < 4; ++ks) {
        const bf16x8 b0 = *(const bf16x8*)&ST[r][ks * 32 + quad * 8], b1 = *(const bf16x8*)&ST[16 + r][ks * 32 + quad * 8];
#pragma unroll
        for (int mt = 0; mt < 2; ++mt) { xa[mt][0] = mfma16(f.aw[mt][ks], b0, xa[mt][0]); xa[mt][1] = mfma16(f.aw[mt][ks], b1, xa[mt][1]); }
    }
    const size_t cbase = (size_t)(h * 128 + n) * CH;
#pragma unroll
    for (int mt = 0; mt < 2; ++mt)
#pragma unroll
        for (int nt = 0; nt < 2; ++nt) {
            const uint2 uu = f.u[mt][nt];
            const uint2 p = pack4(__uint_as_float(uu.x << 16) - xa[mt][nt][0], __uint_as_float(uu.x & 0xffff0000u) - xa[mt][nt][1],
                                  __uint_as_float(uu.y << 16) - xa[mt][nt][2], __uint_as_float(uu.y & 0xffff0000u) - xa[mt][nt][3]);
            *(uint2*)&VT[16 * nt + r][32 * w + 16 * mt + quad * 4] = p;
            *(uint2*)(VnT + cbase + (size_t)(32 * c + 16 * nt + r) * 128 + 32 * w + 16 * mt + quad * 4) = p;
        }
    __syncthreads();
#pragma unroll
    for (int mt = 0; mt < 2; ++mt)
#pragma unroll
        for (int nt = 0; nt < 2; ++nt) s[mt][nt] *= f.dec;
#pragma unroll
    for (int ks = 0; ks < 4; ++ks) {
        const bf16x8 b0 = *(const bf16x8*)&VT[r][ks * 32 + quad * 8], b1 = *(const bf16x8*)&VT[16 + r][ks * 32 + quad * 8];
#pragma unroll
        for (int mt = 0; mt < 2; ++mt) { s[mt][0] = mfma16(f.ak[mt][ks], b0, s[mt][0]); s[mt][1] = mfma16(f.ak[mt][ks], b1, s[mt][1]); }
    }
#pragma unroll
    for (int mt = 0; mt < 2; ++mt)
#pragma unroll
        for (int nt = 0; nt < 2; ++nt) {
            const uint2 p = pack4(s[mt][nt][0], s[mt][nt][1], s[mt][nt][2], s[mt][nt][3]);
            *(uint2*)&ST[16 * nt + r][32 * w + 16 * mt + quad * 4] = p;
            if (n + 1 < 128) *(uint2*)(Sst + cbase + CH + (size_t)(32 * c + 16 * nt + r) * 128 + 32 * w + 16 * mt + quad * 4) = p;
        }
    __syncthreads();
}
__device__ __forceinline__ void gdn_scan(int b, unsigned char* smem, const bf16_t* __restrict__ UT, const bf16_t* __restrict__ Wm, const bf16_t* __restrict__ KstT,
                                         const float* __restrict__ gcb, bf16_t* __restrict__ VnT, bf16_t* __restrict__ Sst) {
    const int h = b >> 2, c = b & 3;
    const int tid = threadIdx.x, lane = tid & 63, w = tid >> 6, r = lane & 15, quad = lane >> 4;
    bf16_t (*ST)[LDT] = (bf16_t(*)[LDT])smem;
    bf16_t (*VT)[LDT] = (bf16_t(*)[LDT])(smem + 32 * LDT * 2);
    for (int u = tid; u < 32 * LDT / 2; u += 256) ((unsigned*)smem)[u] = 0u;
    {
        const size_t cb0 = (size_t)(h * 128) * CH;
        for (int u = tid; u < 32 * 16; u += 256) *(uint4*)(Sst + cb0 + (size_t)(32 * c + (u >> 4)) * 128 + (u & 15) * 8) = make_uint4(0u, 0u, 0u, 0u);
    }
    f32x4 s[2][2];
#pragma unroll
    for (int mt = 0; mt < 2; ++mt)
#pragma unroll
        for (int nt = 0; nt < 2; ++nt) s[mt][nt] = (f32x4){0.f, 0.f, 0.f, 0.f};
    __syncthreads();
    ScanFrags f0, f1;
    scan_load(f0, h, 0, c, w, r, quad, UT, Wm, KstT, gcb);
    for (int n = 0; n < 128; n += 2) {
        scan_load(f1, h, n + 1, c, w, r, quad, UT, Wm, KstT, gcb);
        scan_step(f0, s, h, n, c, w, r, quad, ST, VT, VnT, Sst);
        scan_load(f0, h, (n + 2 < 128) ? n + 2 : 127, c, w, r, quad, UT, Wm, KstT, gcb);
        scan_step(f1, s, h, n + 1, c, w, r, quad, ST, VT, VnT, Sst);
    }
}

__device__ __forceinline__ void gdn_phaseC(int item, unsigned char* smem, const bf16_t* __restrict__ projb, const float* __restrict__ conv_w, const bf16_t* __restrict__ kn,
                                           const float* __restrict__ gcb, const bf16_t* __restrict__ VnT, const bf16_t* __restrict__ Sst,
                                           const float* __restrict__ gdn_norm_w, bf16_t* __restrict__ mixed) {
    const int h = item & 3, n = item >> 2, t0 = n * 128;
    int tid_ = threadIdx.x; asm volatile("" : "+v"(tid_));
    const int tid = tid_, lane = tid & 63, w = tid >> 6;
    const int wr = w >> 1, wc = w & 1, r = lane & 15, quad = lane >> 4;
    { int zoff = 0; asm volatile("" : "+s"(zoff)); smem += zoff; }
    float* gcs = (float*)smem;
    float* cw = gcs + 128;
    float* red = cw + 512;
    bf16_t (*Qt)[LDT] = (bf16_t(*)[LDT])(smem + 3584);
    bf16_t (*Kt)[LDT] = (bf16_t(*)[LDT])(smem + 3584 + 128 * LDT * 2);
    const size_t cbase = (size_t)(h * 128 + n) * CH;
    if (tid < 128) gcs[tid] = gcb[(size_t)(h * 128 + n) * 128 + tid];
    for (int u = tid; u < 512; u += 256) cw[u] = conv_w[(u >> 7) * 1536 + h * 128 + (u & 127)];
#pragma unroll
    for (int j = 0; j < 8; ++j) {
        const int c = tid + 256 * j, row = c >> 4, cc = c & 15;
        *(uint4*)&Kt[row][cc * 8] = *(const uint4*)(kn + (size_t)(t0 + row) * 512 + h * 128 + cc * 8);
    }
    __syncthreads();
    conv_norm_rows(tid, projb, t0, C_GQ + h * 128, cw, Qt, nullptr);
    __syncthreads();
    f32x4 acc[4][4];
#pragma unroll
    for (int i = 0; i < 4; ++i)
#pragma unroll
        for (int j = 0; j < 4; ++j) acc[i][j] = (f32x4){0.f, 0.f, 0.f, 0.f};
    if (!(wr == 0 && wc == 1)) {
#pragma unroll
        for (int ks = 0; ks < 4; ++ks) {
            bf16x8 a[4], b[4];
#pragma unroll
            for (int i = 0; i < 4; ++i) a[i] = *(const bf16x8*)&Qt[wr * 64 + i * 16 + r][ks * 32 + quad * 8];
#pragma unroll
            for (int j = 0; j < 4; ++j) b[j] = *(const bf16x8*)&Kt[wc * 64 + j * 16 + r][ks * 32 + quad * 8];
#pragma unroll
            for (int i = 0; i < 4; ++i)
#pragma unroll
                for (int j = 0; j < 4; ++j) acc[i][j] = mfma16(b[j], a[i], acc[i][j]);
        }
    }
    __syncthreads();
#pragma unroll
    for (int i = 0; i < 4; ++i) {
        const int row = wr * 64 + i * 16 + r;
        const float gi = gcs[row];
#pragma unroll
        for (int j = 0; j < 4; ++j) {
            const int c0 = wc * 64 + j * 16 + quad * 4;
            float o[4];
#pragma unroll
            for (int v = 0; v < 4; ++v) o[v] = (c0 + v <= row) ? acc[i][j][v] * QSCALE * __expf(gi - gcs[c0 + v]) : 0.f;
            *(uint2*)&Kt[row][c0] = pack4(o[0], o[1], o[2], o[3]);
        }
    }
    __syncthreads();
#pragma unroll
    for (int i = 0; i < 4; ++i)
#pragma unroll
        for (int j = 0; j < 4; ++j) acc[i][j] = (f32x4){0.f, 0.f, 0.f, 0.f};
#pragma unroll
    for (int ks = 0; ks < 4; ++ks) {
        bf16x8 a[4], b[4];
#pragma unroll
        for (int i = 0; i < 4; ++i) a[i] = *(const bf16x8*)&Qt[wr * 64 + i * 16 + r][ks * 32 + quad * 8];
#pragma unroll
        for (int j = 0; j < 4; ++j) b[j] = *(const bf16x8*)(Sst + cbase + (size_t)(wc * 64 + j * 16 + r) * 128 + ks * 32 + quad * 8);
#pragma unroll
        for (int i = 0; i < 4; ++i)
#pragma unroll
            for (int j = 0; j < 4; ++j) acc[i][j] = mfma16(b[j], a[i], acc[i][j]);
    }
#pragma unroll
    for (int i = 0; i < 4; ++i) {
        const float sc = QSCALE * __expf(gcs[wr * 64 + i * 16 + r]);
#pragma unroll
        for (int j = 0; j < 4; ++j) acc[i][j] *= sc;
    }
#pragma unroll
    for (int ks = 0; ks < 4; ++ks) {
        bf16x8 a[4], b[4];
#pragma unroll
        for (int i = 0; i < 4; ++i) a[i] = *(const bf16x8*)&Kt[wr * 64 + i * 16 + r][ks * 32 + quad * 8];
#pragma unroll
        for (int j = 0; j < 4; ++j) b[j] = *(const bf16x8*)(VnT + cbase + (size_t)(wc * 64 + j * 16 + r) * 128 + ks * 32 + quad * 8);
#pragma unroll
        for (int i = 0; i < 4; ++i)
#pragma unroll
            for (int j = 0; j < 4; ++j) acc[i][j] = mfma16(b[j], a[i], acc[i][j]);
    }
#pragma unroll
    for (int i = 0; i < 4; ++i) {
        float ss = 0.f;
#pragma unroll
        for (int j = 0; j < 4; ++j)
#pragma unroll
            for (int v = 0; v < 4; ++v) ss += acc[i][j][v] * acc[i][j][v];
        ss += __shfl_xor(ss, 16); ss += __shfl_xor(ss, 32);
        if (quad == 0) red[wc * 128 + wr * 64 + i * 16 + r] = ss;
    }
    __syncthreads();
#pragma unroll
    for (int i = 0; i < 4; ++i) {
        const int row = wr * 64 + i * 16 + r;
        const float rs = rsqrtf((red[row] + red[128 + row]) * (1.f / 128.f) + EPS);
#pragma unroll
        for (int j = 0; j < 4; ++j) {
            const int e0 = wc * 64 + j * 16 + quad * 4;
            const uint2 gz = *(const uint2*)(projb + (size_t)(t0 + row) * NPROJ + C_GZ + h * 128 + e0);
            const float4 nw = *(const float4*)(gdn_norm_w + e0);
            const uint2 p = pack4(acc[i][j][0] * rs * nw.x * silu(__uint_as_float(gz.x << 16)), acc[i][j][1] * rs * nw.y * silu(__uint_as_float(gz.x & 0xffff0000u)),
                                  acc[i][j][2] * rs * nw.z * silu(__uint_as_float(gz.y << 16)), acc[i][j][3] * rs * nw.w * silu(__uint_as_float(gz.y & 0xffff0000u)));
            *(uint2*)(mixed + (size_t)(t0 + row) * 1024 + 512 + h * 128 + e0) = p;
        }
    }
    __syncthreads();
}


__device__ __forceinline__ void ret_phaseA(int item, unsigned char* smem, const bf16_t* __restrict__ projb,
                                           bf16_t* __restrict__ rqr, bf16_t* __restrict__ rkr, bf16_t* __restrict__ VTg, float* __restrict__ kvT) {
    const int h = item & 3, n = item >> 2, t0 = n * 128;
    int tid_ = threadIdx.x; asm volatile("" : "+v"(tid_));
    const int tid = tid_, lane = tid & 63, w = tid >> 6, r = lane & 15, quad = lane >> 4;
    { int zoff = 0; asm volatile("" : "+s"(zoff)); smem += zoff; }
    bf16_t (*VT)[LDT] = (bf16_t(*)[LDT])smem;
    bf16_t (*KT)[LDT] = (bf16_t(*)[LDT])(smem + 128 * LDT * 2);
    const float lg2 = log2f(1.f - exp2f(-5.f - (float)h));
    {
        const int i = tid >> 1, hf = tid & 1, t = t0 + i;
        const bf16_t* pq = projb + (size_t)t * NPROJ + C_RQ + h * 64 + hf * 16;
        const bf16_t* pk = projb + (size_t)t * NPROJ + C_RK + h * 64 + hf * 16;
        uint4 ql[2], qh[2], kl[2], kh[2];
        ql[0] = *(const uint4*)pq; ql[1] = *(const uint4*)(pq + 8); qh[0] = *(const uint4*)(pq + 32); qh[1] = *(const uint4*)(pq + 40);
        kl[0] = *(const uint4*)pk; kl[1] = *(const uint4*)(pk + 8); kh[0] = *(const uint4*)(pk + 32); kh[1] = *(const uint4*)(pk + 40);
        const unsigned* qlw = (const unsigned*)ql; const unsigned* qhw = (const unsigned*)qh; const unsigned* klw = (const unsigned*)kl; const unsigned* khw = (const unsigned*)kh;
        const float kdec = exp2f((float)(127 - i) * lg2);
        unsigned oql[8], oqh[8], okl[8], okh[8];
#pragma unroll
        for (int p = 0; p < 8; ++p) {
            float q1[2], q2[2], k1[2], k2[2];
#pragma unroll
            for (int s = 0; s < 2; ++s) {
                const int j = hf * 16 + 2 * p + s;
                double u = (double)t * INVREV[j];
                u -= rint(u);
                const float fr = (float)u;
                const float sn = __builtin_amdgcn_sinf(fr), cs = __builtin_amdgcn_cosf(fr);
                const float qa = s ? __uint_as_float(qlw[p] & 0xffff0000u) : __uint_as_float(qlw[p] << 16);
                const float qb = s ? __uint_as_float(qhw[p] & 0xffff0000u) : __uint_as_float(qhw[p] << 16);
                const float ka = s ? __uint_as_float(klw[p] & 0xffff0000u) : __uint_as_float(klw[p] << 16);
                const float kb = s ? __uint_as_float(khw[p] & 0xffff0000u) : __uint_as_float(khw[p] << 16);
                q1[s] = qa * cs - qb * sn; q2[s] = qa * sn + qb * cs;
                k1[s] = (ka * cs - kb * sn) * 0.125f; k2[s] = (ka * sn + kb * cs) * 0.125f;
                KT[j][i] = f2bf(k1[s] * kdec);
                KT[j + 32][i] = f2bf(k2[s] * kdec);
            }
            oql[p] = (unsigned)f2bf(q1[0]) | ((unsigned)f2bf(q1[1]) << 16); oqh[p] = (unsigned)f2bf(q2[0]) | ((unsigned)f2bf(q2[1]) << 16);
            okl[p] = (unsigned)f2bf(k1[0]) | ((unsigned)f2bf(k1[1]) << 16); okh[p] = (unsigned)f2bf(k2[0]) | ((unsigned)f2bf(k2[1]) << 16);
        }
        bf16_t* oq = rqr + (size_t)t * 256 + h * 64 + hf * 16;
        bf16_t* ok = rkr + (size_t)t * 256 + h * 64 + hf * 16;
        *(uint4*)oq = make_uint4(oql[0], oql[1], oql[2], oql[3]); *(uint4*)(oq + 8) = make_uint4(oql[4], oql[5], oql[6], oql[7]);
        *(uint4*)(oq + 32) = make_uint4(oqh[0], oqh[1], oqh[2], oqh[3]); *(uint4*)(oq + 40) = make_uint4(oqh[4], oqh[5], oqh[6], oqh[7]);
        *(uint4*)ok = make_uint4(okl[0], okl[1], okl[2], okl[3]); *(uint4*)(ok + 8) = make_uint4(okl[4], okl[5], okl[6], okl[7]);
        *(uint4*)(ok + 32) = make_uint4(okh[0], okh[1], okh[2], okh[3]); *(uint4*)(ok + 40) = make_uint4(okh[4], okh[5], okh[6], okh[7]);
        const bf16_t* pv = projb + (size_t)t * NPROJ + C_RV + h * 128 + hf * 64;
#pragma unroll
        for (int g = 0; g < 8; ++g) {
            const uint4 raw = *(const uint4*)(pv + g * 8);
            const int e = hf * 64 + g * 8;
            VT[e + 0][i] = (bf16_t)(raw.x & 0xffffu); VT[e + 1][i] = (bf16_t)(raw.x >> 16);
            VT[e + 2][i] = (bf16_t)(raw.y & 0xffffu); VT[e + 3][i] = (bf16_t)(raw.y >> 16);
            VT[e + 4][i] = (bf16_t)(raw.z & 0xffffu); VT[e + 5][i] = (bf16_t)(raw.z >> 16);
            VT[e + 6][i] = (bf16_t)(raw.w & 0xffffu); VT[e + 7][i] = (bf16_t)(raw.w >> 16);
        }
    }
    __syncthreads();
    const size_t cbase = (size_t)(h * 128 + n) * CH;
#pragma unroll
    for (int j = 0; j < 8; ++j) {
        const int c = tid + 256 * j, row = c >> 4, cc = c & 15;
        *(uint4*)(VTg + cbase + (size_t)row * 128 + cc * 8) = *(const uint4*)&VT[row][cc * 8];
    }
    f32x4 acc[2][4];
#pragma unroll
    for (int mt = 0; mt < 2; ++mt)
#pragma unroll
        for (int nt = 0; nt < 4; ++nt) acc[mt][nt] = (f32x4){0.f, 0.f, 0.f, 0.f};
#pragma unroll
    for (int ks = 0; ks < 4; ++ks) {
        bf16x8 a[2], b[4];
#pragma unroll
        for (int mt = 0; mt < 2; ++mt) a[mt] = *(const bf16x8*)&VT[32 * w + 16 * mt + r][ks * 32 + quad * 8];
#pragma unroll
        for (int nt = 0; nt < 4; ++nt) b[nt] = *(const bf16x8*)&KT[16 * nt + r][ks * 32 + quad * 8];
#pragma unroll
        for (int mt = 0; mt < 2; ++mt)
#pragma unroll
            for (int nt = 0; nt < 4; ++nt) acc[mt][nt] = mfma16(b[nt], a[mt], acc[mt][nt]);
    }
    float* kvp = kvT + (size_t)(h * 128 + n) * 8192;
#pragma unroll
    for (int mt = 0; mt < 2; ++mt)
#pragma unroll
        for (int nt = 0; nt < 4; ++nt)
            *(float4*)(kvp + (size_t)(32 * w + 16 * mt + r) * 64 + 16 * nt + quad * 4) = make_float4(acc[mt][nt][0], acc[mt][nt][1], acc[mt][nt][2], acc[mt][nt][3]);
    __syncthreads();
}

__device__ __forceinline__ void ret_scan(int gid, const float* __restrict__ kvT, bf16_t* __restrict__ Srt) {
    const int h = gid >> 13, rem = gid & 8191;
    const float Gam = exp2f(128.f * log2f(1.f - exp2f(-5.f - (float)h)));
    float S = 0.f;
    const float* kp = kvT + (size_t)h * 128 * 8192 + rem;
    bf16_t* sp = Srt + (size_t)h * 128 * 8192 + rem;
    for (int n0 = 0; n0 < 128; n0 += 8) {
        float kv[8];
#pragma unroll
        for (int i = 0; i < 8; ++i) kv[i] = kp[(size_t)(n0 + i) * 8192];
#pragma unroll
        for (int i = 0; i < 8; ++i) { sp[(size_t)(n0 + i) * 8192] = f2bf(S); S = Gam * S + kv[i]; }
    }
}

__device__ __forceinline__ void ret_phaseC(int item, unsigned char* smem, const bf16_t* __restrict__ projb, const bf16_t* __restrict__ rqr, const bf16_t* __restrict__ rkr,
                                           const bf16_t* __restrict__ VTg, const bf16_t* __restrict__ Srt, const float* __restrict__ ret_norm_w, bf16_t* __restrict__ mixed) {
    const int h = item & 3, n = item >> 2, t0 = n * 128;
    int tid_ = threadIdx.x; asm volatile("" : "+v"(tid_));
    const int tid = tid_, lane = tid & 63, w = tid >> 6;
    const int wr = w >> 1, wc = w & 1, r = lane & 15, quad = lane >> 4;
    { int zoff = 0; asm volatile("" : "+s"(zoff)); smem += zoff; }
    float* red = (float*)smem;
    bf16_t (*Qr)[GLD] = (bf16_t(*)[GLD])(smem + 2048);
    bf16_t (*Kr)[GLD] = (bf16_t(*)[GLD])(smem + 2048 + 128 * GLD * 2);
    bf16_t (*Sc)[LDT] = (bf16_t(*)[LDT])(smem + 2048 + 2 * 128 * GLD * 2);
    const float lg2 = log2f(1.f - exp2f(-5.f - (float)h));
#pragma unroll
    for (int j = 0; j < 4; ++j) {
        const int c = tid + 256 * j, row = c >> 3, cc = c & 7;
        *(uint4*)&Qr[row][cc * 8] = *(const uint4*)(rqr + (size_t)(t0 + row) * 256 + h * 64 + cc * 8);
        *(uint4*)&Kr[row][cc * 8] = *(const uint4*)(rkr + (size_t)(t0 + row) * 256 + h * 64 + cc * 8);
    }
    __syncthreads();
    f32x4 acc[4][4];
#pragma unroll
    for (int i = 0; i < 4; ++i)
#pragma unroll
        for (int j = 0; j < 4; ++j) acc[i][j] = (f32x4){0.f, 0.f, 0.f, 0.f};
    if (!(wr == 0 && wc == 1)) {
#pragma unroll
        for (int ks = 0; ks < 2; ++ks) {
            bf16x8 a[4], b[4];
#pragma unroll
            for (int i = 0; i < 4; ++i) a[i] = *(const bf16x8*)&Qr[wr * 64 + i * 16 + r][ks * 32 + quad * 8];
#pragma unroll
            for (int j = 0; j < 4; ++j) b[j] = *(const bf16x8*)&Kr[wc * 64 + j * 16 + r][ks * 32 + quad * 8];
#pragma unroll
            for (int i = 0; i < 4; ++i)
#pragma unroll
                for (int j = 0; j < 4; ++j) acc[i][j] = mfma16(b[j], a[i], acc[i][j]);
        }
    }
#pragma unroll
    for (int i = 0; i < 4; ++i) {
        const int row = wr * 64 + i * 16 + r;
#pragma unroll
        for (int j = 0; j < 4; ++j) {
            const int c0 = wc * 64 + j * 16 + quad * 4;
            float o[4];
#pragma unroll
            for (int v = 0; v < 4; ++v) o[v] = (c0 + v <= row) ? acc[i][j][v] * exp2f((float)(row - c0 - v) * lg2) : 0.f;
            *(uint2*)&Sc[row][c0] = pack4(o[0], o[1], o[2], o[3]);
        }
    }
    __syncthreads();
    const size_t cbase = (size_t)(h * 128 + n) * CH;
    const bf16_t* sp = Srt + (size_t)(h * 128 + n) * 8192;
#pragma unroll
    for (int i = 0; i < 4; ++i)
#pragma unroll
        for (int j = 0; j < 4; ++j) acc[i][j] = (f32x4){0.f, 0.f, 0.f, 0.f};
#pragma unroll
    for (int ks = 0; ks < 2; ++ks) {
        bf16x8 a[4], b[4];
#pragma unroll
        for (int i = 0; i < 4; ++i) a[i] = *(const bf16x8*)&Qr[wr * 64 + i * 16 + r][ks * 32 + quad * 8];
#pragma unroll
        for (int j = 0; j < 4; ++j) b[j] = *(const bf16x8*)(sp + (size_t)(wc * 64 + j * 16 + r) * 64 + ks * 32 + quad * 8);
#pragma unroll
        for (int i = 0; i < 4; ++i)
#pragma unroll
            for (int j = 0; j < 4; ++j) acc[i][j] = mfma16(b[j], a[i], acc[i][j]);
    }
#pragma unroll
    for (int i = 0; i < 4; ++i) {
        const float sc = exp2f((float)(wr * 64 + i * 16 + r + 1) * lg2);
#pragma unroll
        for (int j = 0; j < 4; ++j) acc[i][j] *= sc;
    }
#pragma unroll
    for (int ks = 0; ks < 4; ++ks) {
        bf16x8 a[4], b[4];
#pragma unroll
        for (int i = 0; i < 4; ++i) a[i] = *(const bf16x8*)&Sc[wr * 64 + i * 16 + r][ks * 32 + quad * 8];
#pragma unroll
        for (int j = 0; j < 4; ++j) b[j] = *(const bf16x8*)(VTg + cbase + (size_t)(wc * 64 + j * 16 + r) * 128 + ks * 32 + quad * 8);
#pragma unroll
        for (int i = 0; i < 4; ++i)
#pragma unroll
            for (int j = 0; j < 4; ++j) acc[i][j] = mfma16(b[j], a[i], acc[i][j]);
    }
#pragma unroll
    for (int i = 0; i < 4; ++i) {
        float s1 = 0.f, s2 = 0.f;
#pragma unroll
        for (int j = 0; j < 4; ++j)
#pragma unroll
            for (int v = 0; v < 4; ++v) { s1 += acc[i][j][v]; s2 += acc[i][j][v] * acc[i][j][v]; }
        s1 += __shfl_xor(s1, 16); s1 += __shfl_xor(s1, 32);
        s2 += __shfl_xor(s2, 16); s2 += __shfl_xor(s2, 32);
        if (quad == 0) { red[wc * 128 + wr * 64 + i * 16 + r] = s1; red[256 + wc * 128 + wr * 64 + i * 16 + r] = s2; }
    }
    __syncthreads();
#pragma unroll
    for (int i = 0; i < 4; ++i) {
        const int row = wr * 64 + i * 16 + r;
        const float mu = (red[row] + red[128 + row]) * (1.f / 128.f);
        const float var = fmaxf((red[256 + row] + red[384 + row]) * (1.f / 128.f) - mu * mu, 0.f);
        const float rs = rsqrtf(var + EPS);
#pragma unroll
        for (int j = 0; j < 4; ++j) {
            const int e0 = wc * 64 + j * 16 + quad * 4;
            const uint2 gz = *(const uint2*)(projb + (size_t)(t0 + row) * NPROJ + C_RG + h * 128 + e0);
            const float4 nw = *(const float4*)(ret_norm_w + h * 128 + e0);
            const uint2 p = pack4((acc[i][j][0] - mu) * rs * nw.x * silu(__uint_as_float(gz.x << 16)), (acc[i][j][1] - mu) * rs * nw.y * silu(__uint_as_float(gz.x & 0xffff0000u)),
                                  (acc[i][j][2] - mu) * rs * nw.z * silu(__uint_as_float(gz.y << 16)), (acc[i][j][3] - mu) * rs * nw.w * silu(__uint_as_float(gz.y & 0xffff0000u)));
            *(uint2*)(mixed + (size_t)(t0 + row) * 1024 + h * 128 + e0) = p;
        }
    }
    __syncthreads();
}


__device__ __forceinline__ void k_rope(int bid, const bf16_t* __restrict__ projb, bf16_t* __restrict__ rqr, bf16_t* __restrict__ rkr) {
    const int t = bid, tid = threadIdx.x;
    const int which = tid >> 7, h = (tid >> 5) & 3, j = tid & 31;
    const bf16_t* p = projb + (size_t)t * NPROJ + which * 256 + h * 64;
    const float a = bf2f(p[j]), b = bf2f(p[j + 32]);
    double u = (double)t * INVREV[j];
    u -= rint(u);
    const float fr = (float)u;
    const float sn = __builtin_amdgcn_sinf(fr), cs = __builtin_amdgcn_cosf(fr);
    const float sc = which ? 0.125f : 1.f;
    bf16_t* o = (which ? rkr : rqr) + (size_t)t * 256 + h * 64;
    o[j] = f2bf((a * cs - b * sn) * sc);
    o[j + 32] = f2bf((a * sn + b * cs) * sc);
}
__device__ __forceinline__ void k_mixnorm_ret(int bid, const float* __restrict__ o_r, const bf16_t* __restrict__ projb, const float* __restrict__ ret_norm_w, bf16_t* __restrict__ mixed) {
    const int gw = bid * 4 + (threadIdx.x >> 6), l = threadIdx.x & 63;
    const int t = gw >> 2, g = gw & 3;
    const float2 o = *(const float2*)(o_r + (size_t)t * 512 + g * 128 + 2 * l);
    const float mu = wave_sum(o.x + o.y) * (1.f / 128.f);
    const float d0 = o.x - mu, d1 = o.y - mu;
    const float var = wave_sum(d0 * d0 + d1 * d1) * (1.f / 128.f);
    const float rs = rsqrtf(var + EPS);
    const bf16_t* gp = projb + (size_t)t * NPROJ + C_RG + g * 128 + 2 * l;
    const float y0 = d0 * rs * ret_norm_w[g * 128 + 2 * l] * silu(bf2f(gp[0]));
    const float y1 = d1 * rs * ret_norm_w[g * 128 + 2 * l + 1] * silu(bf2f(gp[1]));
    bf16_t* mp = mixed + (size_t)t * 1024 + g * 128 + 2 * l;
    mp[0] = f2bf(y0); mp[1] = f2bf(y1);
}

constexpr float U_SCALE = 256.f, V_SCALE = 32.f;
__device__ __forceinline__ void k_tab8(int gid, const float* __restrict__ src, unsigned char* __restrict__ dst, float scale) {
    const float4* sp = (const float4*)(src + (size_t)gid * 16);
    unsigned wv[4];
#pragma unroll
    for (int m = 0; m < 4; ++m) {
        const float4 v = sp[m];
        int w = __builtin_amdgcn_cvt_pk_fp8_f32(v.x * scale, v.y * scale, 0, false);
        w = __builtin_amdgcn_cvt_pk_fp8_f32(v.z * scale, v.w * scale, w, true);
        wv[m] = (unsigned)w;
    }
    *(uint4*)(dst + (size_t)gid * 16) = make_uint4(wv[0], wv[1], wv[2], wv[3]);
}
typedef __attribute__((ext_vector_type(2))) float f32x2;
__device__ __forceinline__ float dot16_fp8(const uint4 r, const float (&h)[16]) {
    float d = 0.f;
    const unsigned wv[4] = {r.x, r.y, r.z, r.w};
#pragma unroll
    for (int m = 0; m < 4; ++m) {
        const f32x2 lo = __builtin_amdgcn_cvt_pk_f32_fp8((int)wv[m], false), hi = __builtin_amdgcn_cvt_pk_f32_fp8((int)wv[m], true);
        d += lo.x * h[4 * m] + lo.y * h[4 * m + 1] + hi.x * h[4 * m + 2] + hi.y * h[4 * m + 3];
    }
    return d;
}
__device__ __forceinline__ void axpy16_fp8(const uint4 r, float c, float (&a)[16]) {
    const unsigned wv[4] = {r.x, r.y, r.z, r.w};
#pragma unroll
    for (int m = 0; m < 4; ++m) {
        const f32x2 lo = __builtin_amdgcn_cvt_pk_f32_fp8((int)wv[m], false), hi = __builtin_amdgcn_cvt_pk_f32_fp8((int)wv[m], true);
        a[4 * m] += c * lo.x; a[4 * m + 1] += c * lo.y; a[4 * m + 2] += c * hi.x; a[4 * m + 3] += c * hi.y;
    }
}
__device__ __forceinline__ void k_peer8(int bid, const float* x2, const float* __restrict__ r2, const float* __restrict__ ln2_w,
                                        const int* __restrict__ sel_id, const float* __restrict__ sel_g,
                                        const unsigned char* __restrict__ u8, const unsigned char* __restrict__ v8, const float* __restrict__ lnf_w, float* out) {
    const int t = bid * 4 + (threadIdx.x >> 6), lane = threadIdx.x & 63;
    float xv[16], h2[16], acc[16];
    const float rr = r2[t];
#pragma unroll
    for (int m = 0; m < 4; ++m) {
        const float4 v = *(const float4*)(x2 + (size_t)t * 1024 + lane * 16 + 4 * m);
        const float4 w = *(const float4*)(ln2_w + lane * 16 + 4 * m);
        xv[4 * m] = v.x; xv[4 * m + 1] = v.y; xv[4 * m + 2] = v.z; xv[4 * m + 3] = v.w;
        h2[4 * m] = v.x * rr * w.x; h2[4 * m + 1] = v.y * rr * w.y; h2[4 * m + 2] = v.z * rr * w.z; h2[4 * m + 3] = v.w * rr * w.w;
        acc[4 * m] = 0.f; acc[4 * m + 1] = 0.f; acc[4 * m + 2] = 0.f; acc[4 * m + 3] = 0.f;
    }
    const int id0 = sel_id[(size_t)t * 128 + lane], id1 = sel_id[(size_t)t * 128 + 64 + lane];
    const float gg0 = sel_g[(size_t)t * 128 + lane], gg1 = sel_g[(size_t)t * 128 + 64 + lane];
    for (int k0 = 0; k0 < 128; k0 += 8) {
        const int idv = (k0 < 64) ? id0 : id1;
        const float gv = (k0 < 64) ? gg0 : gg1;
        uint4 ur[8], vr[8];
        float gate[8];
#pragma unroll
        for (int j = 0; j < 8; ++j) {
            const int id = __builtin_amdgcn_readlane(idv, (k0 & 63) + j);
            gate[j] = __uint_as_float(__builtin_amdgcn_readlane(__float_as_uint(gv), (k0 & 63) + j));
            ur[j] = *(const uint4*)(u8 + (size_t)id * 1024 + lane * 16);
            vr[j] = *(const uint4*)(v8 + (size_t)id * 1024 + lane * 16);
        }
#pragma unroll
        for (int j = 0; j < 8; ++j) {
            const float d = wave_sum(dot16_fp8(ur[j], h2)) * (1.f / U_SCALE);
            const float c = gate[j] * 0.5f * d * (1.f + erff(d * 0.70710678118654752f)) * (1.f / V_SCALE);
            axpy16_fp8(vr[j], c, acc);
        }
    }
    float ss = 0.f;
#pragma unroll
    for (int m = 0; m < 16; ++m) { acc[m] += xv[m]; ss += acc[m] * acc[m]; }
    ss = wave_sum(ss);
    const float rs = rsqrtf(ss * (1.f / 1024.f) + EPS);
#pragma unroll
    for (int m = 0; m < 4; ++m) {
        const float4 w = *(const float4*)(lnf_w + lane * 16 + 4 * m);
        *(float4*)(out + (size_t)t * 1024 + lane * 16 + 4 * m) = make_float4(acc[4 * m] * rs * w.x, acc[4 * m + 1] * rs * w.y, acc[4 * m + 2] * rs * w.z, acc[4 * m + 3] * rs * w.w);
    }
}

struct Params {
    const float* in[15];
    float* out;
    unsigned char* ws;
};
constexpr size_t MiB = 1024 * 1024;
constexpr size_t OFF_WIN = 0;
constexpr size_t OFF_WOUT = OFF_WIN + (size_t)NPROJ * 1024 * 2;
constexpr size_t OFF_WQ = OFF_WOUT + (size_t)1024 * 1024 * 2;
constexpr size_t OFF_KEYS = OFF_WQ + (size_t)2048 * 1024 * 2;
constexpr size_t OFF_R1 = OFF_KEYS + (size_t)16 * 128 * 128 * 2;
constexpr size_t OFF_R2 = OFF_R1 + 65536;
constexpr size_t OFF_GDEC = OFF_R2 + 65536;
constexpr size_t OFF_BETA = OFF_GDEC + 262144;
constexpr size_t OFF_GCB = OFF_BETA + 262144;
constexpr size_t OFF_C = ((OFF_GCB + 262144 + MiB - 1) / MiB) * MiB;
constexpr size_t OFF_D = OFF_C + 32 * MiB;
constexpr size_t OFF_E = OFF_D + 112 * MiB;
constexpr size_t WS_END = OFF_E + 64 * MiB;
constexpr int SMEM_BYTES = 2 * 2 * 128 * GLD * 2;

#define GRID_LOOP(b, n) for (int b = blockIdx.x; b < (n); b += gridDim.x)
#define GSYNC() do { asm volatile("s_waitcnt vmcnt(0)" ::: "memory"); grid.sync(); \
    if (threadIdx.x < 64) { __builtin_amdgcn_fence(__ATOMIC_ACQUIRE, "agent"); asm volatile("s_waitcnt vmcnt(0)" ::: "memory"); } __syncthreads(); } while (0)

__global__ __launch_bounds__(256) void mega(Params p) {
    cg::grid_group grid = cg::this_grid();
    __shared__ __attribute__((aligned(16))) unsigned char smem[SMEM_BYTES];
    const float* x = p.in[0]; const float* ln1_w = p.in[1]; const float* w_in = p.in[2]; const float* ret_norm_w = p.in[3];
    const float* conv_w = p.in[4]; const float* A_log = p.in[5]; const float* dt_bias = p.in[6]; const float* gdn_norm_w = p.in[7];
    const float* w_out = p.in[8]; const float* ln2_w = p.in[9]; const float* peer_wq = p.in[10]; const float* peer_keys = p.in[11];
    const float* peer_u = p.in[12]; const float* peer_v = p.in[13]; const float* lnf_w = p.in[14];
    float* out = p.out; unsigned char* ws = p.ws;
    bf16_t* WinT = (bf16_t*)(ws + OFF_WIN); bf16_t* WoutT = (bf16_t*)(ws + OFF_WOUT); bf16_t* WqT = (bf16_t*)(ws + OFF_WQ); bf16_t* keysb = (bf16_t*)(ws + OFF_KEYS);
    float* r1 = (float*)(ws + OFF_R1); float* r2 = (float*)(ws + OFF_R2); float* gdec = (float*)(ws + OFF_GDEC); float* beta = (float*)(ws + OFF_BETA);
    bf16_t* xb = (bf16_t*)(ws + OFF_C); bf16_t* x2b = xb;
    bf16_t* projb = (bf16_t*)(ws + OFF_D); bf16_t* qp = projb;
    unsigned* top1 = (unsigned*)(ws + OFF_D + 64 * MiB); int* sel_id = (int*)(ws + OFF_D + 80 * MiB); float* sel_g = (float*)(ws + OFF_D + 88 * MiB);
    bf16_t* UT = (bf16_t*)(ws + OFF_E); bf16_t* mixed = UT; bf16_t* Wm = (bf16_t*)(ws + OFF_E + 16 * MiB); bf16_t* KstT = (bf16_t*)(ws + OFF_E + 32 * MiB);
    bf16_t* kn = (bf16_t*)(ws + OFF_E + 48 * MiB);
    unsigned char* u8 = ws + OFF_E + 32 * MiB; unsigned char* v8 = ws + OFF_E + 48 * MiB;
    bf16_t* VnT = (bf16_t*)(ws + OFF_C); bf16_t* Sst = (bf16_t*)(ws + OFF_C + 16 * MiB);
    float* gcb = (float*)(ws + OFF_GCB);
    float* kvT = out; bf16_t* Srt = (bf16_t*)((unsigned char*)out + 16 * MiB);
    bf16_t* rqr = (bf16_t*)((unsigned char*)out + 24 * MiB); bf16_t* rkr = (bf16_t*)((unsigned char*)out + 32 * MiB); bf16_t* VTg = (bf16_t*)((unsigned char*)out + 40 * MiB);

    GRID_LOOP(b, T_ / 4) k_prep_x(b, x, ln1_w, w_in, A_log, dt_bias, xb, r1, gdec, beta);
    GRID_LOOP(b, (NPROJ / 32) * 32) k_transpose(b % (NPROJ / 32), b / (NPROJ / 32), (float(*)[33])smem, w_in, LDWIN, ln1_w, WinT, 1024);
    GRID_LOOP(b, 32 * 32) k_transpose(b % 32, b / 32, (float(*)[33])smem, w_out, 1024, nullptr, WoutT, 1024);
    GRID_LOOP(b, 64 * 32) k_transpose(b % 64, b / 64, (float(*)[33])smem, peer_wq, 2048, ln2_w, WqT, 1024);
    GRID_LOOP(b, (16 * 128 * 128 / 4) / 256) k_convert(b, peer_keys, keysb, 16 * 128 * 128 / 4);
    GSYNC();
    GRID_LOOP(b, (T_ / 128) * (NPROJ / 128)) k_gemm<0>(b, smem, xb, 1024, WinT, 1024, 1024, projb, NPROJ, r1, NPROJ / 128);
    GSYNC();
    GRID_LOOP(b, 1024) {
        if (b < 512) gdn_phaseA(b, smem, projb, conv_w, gdec, beta, UT, Wm, KstT, kn, gcb);
        else ret_phaseA(b - 512, smem, projb, rqr, rkr, VTg, kvT);
    }
    GSYNC();
    if (blockIdx.x < 16) gdn_scan(blockIdx.x, smem, UT, Wm, KstT, gcb, VnT, Sst);
    else if (blockIdx.x < 144) ret_scan((blockIdx.x - 16) * 256 + threadIdx.x, kvT, Srt);
    GSYNC();
    GRID_LOOP(b, 1024) {
        if (b < 512) gdn_phaseC(b, smem, projb, conv_w, kn, gcb, VnT, Sst, gdn_norm_w, mixed);
        else ret_phaseC(b - 512, smem, projb, rqr, rkr, VTg, Srt, ret_norm_w, mixed);
    }
    GSYNC();
    GRID_LOOP(b, (T_ / 128) * 8) k_gemm<1>(b, smem, mixed, 1024, WoutT, 1024, 1024, out, 1024, x, 8);
    GSYNC();
    GRID_LOOP(b, T_ / 4) k_rownorm2(b, out, x2b, r2);
    for (int g = blockIdx.x * 256 + threadIdx.x; g < 16384 * 64; g += gridDim.x * 256) { k_tab8(g, peer_u, u8, U_SCALE); k_tab8(g, peer_v, v8, V_SCALE); }
    GSYNC();
    GRID_LOOP(b, (T_ / 128) * 16) k_gemm<0>(b, smem, x2b, 1024, WqT, 1024, 1024, qp, 2048, r2, 16);
    GSYNC();
    GRID_LOOP(b, (T_ / 128) * 16) k_scores_topk(b, smem, qp, keysb, top1);
    GSYNC();
    GRID_LOOP(b, T_ * 8 / 256) k_cand(b, top1, sel_id, sel_g);
    GSYNC();
    GRID_LOOP(b, T_ / 4) k_peer8(b, out, r2, ln2_w, sel_id, sel_g, u8, v8, lnf_w, out);
}

extern "C" void kernel_launch(void* const* d_in, const int* in_sizes, int n_in, void* d_out, int out_size, void* d_ws, size_t ws_size, hipStream_t stream) {
    static int grid_blocks = 0;
    if (!grid_blocks) {
        int dev = 0, cus = 0, per_cu = 0;
        hipGetDevice(&dev);
        hipDeviceGetAttribute(&cus, hipDeviceAttributeMultiprocessorCount, dev);
        hipOccupancyMaxActiveBlocksPerMultiprocessor(&per_cu, mega, 256, 0);
        if (per_cu > 1) per_cu = 1;
        if (per_cu < 1) per_cu = 1;
        grid_blocks = cus * per_cu;
    }
    if (n_in < 15 || ws_size < WS_END) { fprintf(stderr, "kernel_launch: unexpected inputs / workspace (%d inputs, %zu bytes)\n", n_in, ws_size); return; }
    Params p{};
    for (int i = 0; i < 15; ++i) p.in[i] = (const float*)d_in[i];
    p.out = (float*)d_out; p.ws = (unsigned char*)d_ws;
    void* args[] = {&p};
    hipError_t e = hipLaunchCooperativeKernel((const void*)mega, dim3(grid_blocks), dim3(256), args, 0, stream);
    if (e != hipSuccess) fprintf(stderr, "cooperative launch failed: %s (grid %d)\n", hipGetErrorString(e), grid_blocks);
}
```
